# Optimizing an MI355X kernel written in HIP

```python
import math
import jax, jax.numpy as jnp
from jax import lax
import numpy as np

D_MODEL = 1024
BATCH = 16
SEQ = 2048
DEPTH = 1

HEAD_DIM = 64
N_HEADS_FOX = 8
N_HEADS_DSA = 8
N_IDX_HEADS = 8
IDX_DIM = 64
TOPK_MAX = 256
Q_BLOCK = 128
N_BUCKETS = 32
MAX_DISTANCE = 128
D_FF = 2816
EPS = 1e-6
NEG_INF = -1e30

FOX_W = N_HEADS_FOX * HEAD_DIM
DSA_W = N_HEADS_DSA * HEAD_DIM
IDX_Q_W = N_IDX_HEADS * IDX_DIM
IN_SPLITS = (FOX_W, FOX_W, FOX_W, N_HEADS_FOX,
             DSA_W, HEAD_DIM, HEAD_DIM,
             IDX_Q_W, IDX_DIM, N_IDX_HEADS,
             D_MODEL, D_MODEL)
IN_WIDTH = 3 * FOX_W + N_HEADS_FOX + DSA_W + 2 * HEAD_DIM + IDX_Q_W + IDX_DIM + N_IDX_HEADS + 2 * D_MODEL

kernel_name = "hybrid_fox_dsa_macaron_gated"


def rms_norm(x, g):
    xf = x.astype(jnp.float32)
    y = xf * lax.rsqrt(jnp.mean(xf * xf, axis=-1, keepdims=True) + EPS)
    return (y * g.astype(jnp.float32)).astype(x.dtype)


def swiglu_ffn(x, g, w_gate, w_up, w_down):
    h = rms_norm(x, g)
    return (jax.nn.silu(h @ w_gate) * (h @ w_up)) @ w_down


def t5_causal_bucket(rel):
    max_exact = N_BUCKETS // 2
    relf = jnp.maximum(rel, 1).astype(jnp.float32)
    large = max_exact + (jnp.log(relf / max_exact) / math.log(MAX_DISTANCE / max_exact)
                         * (N_BUCKETS - max_exact)).astype(jnp.int32)
    large = jnp.minimum(large, N_BUCKETS - 1)
    return jnp.where(rel < max_exact, rel, large)


def split_columns(z):
    outs, off = [], 0
    for w in IN_SPLITS:
        outs.append(z[..., off:off + w])
        off += w
    return outs


def fox_attention(q, k, v, log_f):
    S = q.shape[1]
    cum = jnp.cumsum(log_f, axis=1).transpose(0, 2, 1)
    scale = HEAD_DIM ** -0.5
    outs = []
    for start in range(0, S, Q_BLOCK):
        end = start + Q_BLOCK
        logits = jnp.einsum('bqhd,bkhd->bhqk', q[:, start:end], k[:, :end]).astype(jnp.float32) * scale
        logits = logits + cum[:, :, start:end, None] - cum[:, :, None, :end]
        qpos = jnp.arange(start, end)[:, None]
        kpos = jnp.arange(end)[None, :]
        logits = jnp.where(kpos <= qpos, logits, NEG_INF)
        p = jax.nn.softmax(logits, axis=-1).astype(v.dtype)
        outs.append(jnp.einsum('bhqk,bkhd->bqhd', p, v[:, :end]))
    return jnp.concatenate(outs, axis=1)


def dsa_attention(q, k, v, q_idx, k_idx, w_idx, rel_bias):
    S = q.shape[1]
    topk = min(TOPK_MAX, S // 4)
    scale = HEAD_DIM ** -0.5
    idx_scale = IDX_DIM ** -0.5
    w = w_idx.astype(jnp.float32) * (N_IDX_HEADS ** -0.5)
    gather = jax.vmap(lambda arr, ind: arr[ind])
    outs = []
    for start in range(0, S, Q_BLOCK):
        end = start + Q_BLOCK
        n_keys = min(S, max(end, topk))
        qpos = jnp.arange(start, end)
        kpos = jnp.arange(n_keys)
        causal = kpos[None, :] <= qpos[:, None]
        s_idx = jax.nn.relu(jnp.einsum('bqhd,bkd->bqhk', q_idx[:, start:end],
                                       k_idx[:, :n_keys]).astype(jnp.float32) * idx_scale)
        score = jnp.einsum('bqhk,bqh->bqk', s_idx, w[:, start:end])
        score = jnp.where(causal[None], score, NEG_INF)
        _, sel = lax.top_k(score, topk)
        valid = sel <= qpos[None, :, None]
        k_sel = gather(k, sel)
        v_sel = gather(v, sel)
        logits = jnp.einsum('bqhd,bqkd->bhqk', q[:, start:end], k_sel).astype(jnp.float32) * scale
        bucket = t5_causal_bucket(jnp.maximum(qpos[None, :, None] - sel, 0))
        bias = rel_bias.astype(jnp.float32)[bucket]
        logits = logits + bias.transpose(0, 3, 1, 2)
        logits = jnp.where(valid[:, None], logits, NEG_INF)
        p = jax.nn.softmax(logits, axis=-1).astype(v.dtype)
        outs.append(jnp.einsum('bhqk,bqkd->bqhd', p, v_sel))
    return jnp.concatenate(outs, axis=1)


def setup_inputs(seed: int = 0) -> dict:
    key = jax.random.key(seed)
    ks = jax.random.split(key, 24)
    f32 = jnp.float32

    def dense(k, fan_in, fan_out):
        return jax.random.normal(k, (fan_in, fan_out), f32) * fan_in ** -0.5

    def gain(k, n):
        return 1.0 + 0.02 * jax.random.normal(k, (n,), f32)

    return {
        "x": jax.random.normal(ks[0], (BATCH, SEQ, D_MODEL), f32),
        "ffn1_norm": gain(ks[1], D_MODEL),
        "ffn1_w_gate": dense(ks[2], D_MODEL, D_FF),
        "ffn1_w_up": dense(ks[3], D_MODEL, D_FF),
        "ffn1_w_down": dense(ks[4], D_FF, D_MODEL),
        "mix_norm": gain(ks[5], D_MODEL),
        "w_in": dense(ks[6], D_MODEL, IN_WIDTH),
        "b_forget": 1.0 + 0.1 * jax.random.normal(ks[7], (N_HEADS_FOX,), f32),
        "fox_q_norm": gain(ks[8], HEAD_DIM),
        "fox_k_norm": gain(ks[9], HEAD_DIM),
        "dsa_q_norm": gain(ks[10], HEAD_DIM),
        "dsa_k_norm": gain(ks[11], HEAD_DIM),
        "rel_bias": 0.5 * jax.random.normal(ks[12], (N_BUCKETS, N_HEADS_DSA), f32),
        "w_branch_a": dense(ks[13], FOX_W, D_MODEL),
        "w_branch_b": dense(ks[14], DSA_W, D_MODEL),
        "w_out": dense(ks[15], D_MODEL, D_MODEL),
        "ffn2_norm": gain(ks[16], D_MODEL),
        "ffn2_w_gate": dense(ks[17], D_MODEL, D_FF),
        "ffn2_w_up": dense(ks[18], D_MODEL, D_FF),
        "ffn2_w_down": dense(ks[19], D_FF, D_MODEL),
    }


def reference(x, ffn1_norm, ffn1_w_gate, ffn1_w_up, ffn1_w_down, mix_norm, w_in, b_forget,
              fox_q_norm, fox_k_norm, dsa_q_norm, dsa_k_norm, rel_bias,
              w_branch_a, w_branch_b, w_out, ffn2_norm, ffn2_w_gate, ffn2_w_up, ffn2_w_down):
    B, S, _ = x.shape
    for _layer in range(DEPTH):
        x = x + 0.5 * swiglu_ffn(x, ffn1_norm, ffn1_w_gate, ffn1_w_up, ffn1_w_down)

        h = rms_norm(x, mix_norm)
        (fq, fk, fv, ff, dq, dk, dv, iq, ik, iw, ga, gb) = split_columns(h @ w_in)

        fq = rms_norm(fq.reshape(B, S, N_HEADS_FOX, HEAD_DIM), fox_q_norm)
        fk = rms_norm(fk.reshape(B, S, N_HEADS_FOX, HEAD_DIM), fox_k_norm)
        fv = fv.reshape(B, S, N_HEADS_FOX, HEAD_DIM)
        log_f = jax.nn.log_sigmoid((ff + b_forget).astype(jnp.float32))
        o_a = fox_attention(fq, fk, fv, log_f).reshape(B, S, FOX_W)

        dq = rms_norm(dq.reshape(B, S, N_HEADS_DSA, HEAD_DIM), dsa_q_norm)
        dk = rms_norm(dk, dsa_k_norm)
        iq = iq.reshape(B, S, N_IDX_HEADS, IDX_DIM)
        o_b = dsa_attention(dq, dk, dv, iq, ik, iw, rel_bias).reshape(B, S, DSA_W)

        merged = jax.nn.sigmoid(ga) * (o_a @ w_branch_a) + jax.nn.sigmoid(gb) * (o_b @ w_branch_b)
        x = x + merged @ w_out

        x = x + 0.5 * swiglu_ffn(x, ffn2_norm, ffn2_w_gate, ffn2_w_up, ffn2_w_down)
    return x
```

```cpp
#include <hip/hip_runtime.h>
#include <hip/hip_bf16.h>
#include <cstdio>
#include <cstdint>

#ifndef MK_N_LAUNCHES
#define MK_N_LAUNCHES 1
#endif
#ifndef MK_STOP_AFTER
#define MK_STOP_AFTER 99
#endif

constexpr int BATCH = 16, SEQ = 2048, DM = 1024, TOK = BATCH * SEQ;
constexpr int DFF = 2816, NGU = 2 * DFF;
constexpr int NIN = 4864, IN_W = 4816;
constexpr int NHEAD = 8, HD = 64, HW = NHEAD * HD;
constexpr int TOPK = 256;
constexpr float EPS = 1e-6f;
constexpr float LOG2E = 1.4426950408889634f;
constexpr float C2 = 0.125f * LOG2E;
constexpr float NEGBIG = -1e30f;

namespace pg8 {
#define PG8_LAS __attribute__((address_space(3)))
typedef unsigned short bf16_t;
typedef short bf16x8 __attribute__((ext_vector_type(8)));
typedef float f32x4 __attribute__((ext_vector_type(4)));
typedef unsigned u32x4 __attribute__((ext_vector_type(4)));
typedef unsigned u32x2 __attribute__((ext_vector_type(2)));
constexpr int BM = 256, BK = 64, HALF = 128, HTB = HALF * BK * 2  , STAGE_BYTES = 8 * HTB, NXCD = 8, WGM = 4;

__host__ __device__ __forceinline__ int lds_byte(int r, int c) { const int st = (r >> 4) * 2 + (c >> 5), rr = r & 15, cc = c & 31, ob = rr * 64 + cc * 2; return st * 1024 + (ob ^ (((ob >> 9) & 1) << 5)); }
__host__ __device__ __forceinline__ void stage_rc(int b, int& R, int& C) { const int st = b / 1024, sb = b % 1024, swz = sb ^ (((sb >> 9) & 1) << 5); R = (st >> 1) * 16 + swz / 64; C = (st & 1) * 32 + (swz % 64) / 2; }
__host__ __device__ __forceinline__ int perm32(int rho) { const int n = rho >> 4, i = rho & 15; return 8 * (i >> 2) + 4 * n + (i & 3); }

struct Unit { int pm, pn, sel, par; };
struct Gemm { const bf16_t* A; const bf16_t* Bt; int M, N, K; const bf16_t* A2; const bf16_t* Bt2; };

struct StaticOrder {
    int nM, nN, nwg, G, c;
    __host__ __device__ void init(int M, int N, int G_, int c_) { nM = M / BM; nN = N / BM; nwg = nM * nN; G = G_; c = c_; }
    __host__ __device__ bool next(int i, Unit& u) const {
        const long L = (long)i * G + c; if (L >= nwg) return false;
        int wgid = (int)L; { const int q = nwg / NXCD, r = nwg % NXCD, xcd = wgid % NXCD, off = wgid / NXCD; wgid = (xcd < r ? xcd * (q + 1) : r * (q + 1) + (xcd - r) * q) + off; }
        const int nig = WGM * nN, gid = wgid / nig, fm = gid * WGM, gsz = (nM - fm) < WGM ? (nM - fm) : WGM;
        u.pm = fm + ((wgid % nig) % gsz); u.pn = (wgid % nig) / gsz; u.sel = 0; return true;
    }
    __device__ __forceinline__ void a_ready(const Unit&) const {}
    __device__ __forceinline__ void done(const Unit&) const {}
};
struct PairOrder {
    StaticOrder so;
    __host__ __device__ bool next(int i, Unit& u) const { if (!so.next(i >> 1, u)) return false; u.sel = i & 1; return true; }
    __device__ __forceinline__ void a_ready(const Unit&) const {}
    __device__ __forceinline__ void done(const Unit&) const {}
};

__device__ __forceinline__ unsigned cvt_pk_bf16(float lo, float hi) { unsigned r; asm volatile("v_cvt_pk_bf16_f32 %0, %1, %2" : "=v"(r) : "v"(lo), "v"(hi)); return r; }
__device__ __forceinline__ u32x4 pack8(const f32x4 a, const f32x4 b) { u32x4 w; w.x = cvt_pk_bf16(a[0], a[1]); w.y = cvt_pk_bf16(a[2], a[3]); w.z = cvt_pk_bf16(b[0], b[1]); w.w = cvt_pk_bf16(b[2], b[3]); return w; }
__device__ __forceinline__ float bf_lo(unsigned w) { return __uint_as_float(w << 16); }
__device__ __forceinline__ float bf_hi(unsigned w) { return __uint_as_float(w & 0xffff0000u); }
constexpr int BF_LDS = 131072 + 512  , RSTD_LDS = 131072 + 1024, GAIN_LDS = RSTD_LDS + 2048;
constexpr int RSTAT_S = GAIN_LDS + 1024;
__device__ __forceinline__ void rowstat_dma(const float* ss, int pm, PG8_LAS unsigned char* lds, int wid, int lane) {
    const char* g = (const char*)(ss + (size_t)pm * BM * 16) + wid * 1024 + lane * 16;
#pragma unroll
    for (int i = 0; i < 2; ++i) __builtin_amdgcn_global_load_lds((const unsigned*)(g + i * 8192), (PG8_LAS unsigned*)(lds + RSTAT_S + wid * 1024 + i * 8192), 16, 0, 0);
}
__device__ __forceinline__ void rowstat_fold(PG8_LAS unsigned char* lds, int par, int tid) {
    const PG8_LAS f32x4* p = (const PG8_LAS f32x4*)(lds + RSTAT_S + (tid >> 1) * 64 + (tid & 1) * 32); const f32x4 a = p[0], b = p[1];
    float t = ((a[0] + a[1]) + (a[2] + a[3])) + ((b[0] + b[1]) + (b[2] + b[3]));
    t += __shfl_xor(t, 1);
    if ((tid & 1) == 0) *(PG8_LAS float*)(lds + RSTD_LDS + par * 1024 + 4 * (tid >> 1)) = __builtin_amdgcn_rsqf(t * (1.0f / 1024.0f) + 1e-6f);
}
__device__ __forceinline__ float rstd_lds(const PG8_LAS unsigned char* lds, int par, int rit) { return *(const PG8_LAS float*)(lds + RSTD_LDS + par * 1024 + 4 * rit); }
__device__ __forceinline__ float rstd_of(const float* p, int fq) { const f32x4 a = *(const f32x4*)(p + 4 * fq); float ss = (a[0] + a[1]) + (a[2] + a[3]);
    ss += __shfl_xor(ss, 16); ss += __shfl_xor(ss, 32);
    return __builtin_amdgcn_rsqf(ss * (1.0f / 1024.0f) + 1e-6f); }
__device__ __forceinline__ float sigmoid_f(float v) { return __builtin_amdgcn_rcpf(1.0f + __builtin_amdgcn_exp2f(-1.4426950408889634f * v)); }

template <bool NORMED> struct EpiGateUp {
    static constexpr bool PERM = true, AFTER_DRAIN = false, CHAIN = false, ROWSTAT = !NORMED;
    bf16_t* H; const float* ss; PG8_LAS unsigned char* lds;
    __device__ __forceinline__ void operator()(const f32x4 (&acc)[2][2][4][2], const Unit& u, int wr, int wc, int fr, int fq) const {
        const int row0 = u.pm * BM + wr * 64 + fr, col0 = u.pn * HALF + wc * 32 + 8 * fq;
#pragma unroll
        for (int ai = 0; ai < 2; ++ai)
#pragma unroll
            for (int m = 0; m < 4; ++m) { const int row = row0 + ai * HALF + m * 16; const float rs = NORMED ? 1.0f : rstd_lds(lds, u.par, wr * 64 + fr + ai * HALF + m * 16);
                f32x4 hv[2];
#pragma unroll
                for (int n = 0; n < 2; ++n) { const f32x4 g = acc[ai][0][m][n] * rs, up = acc[ai][1][m][n] * rs;
                    const f32x4 a = g * (-1.4426950408889634f); f32x4 ex;
#pragma unroll
                    for (int e = 0; e < 4; ++e) ex[e] = __builtin_amdgcn_exp2f(a[e]);
                    const f32x4 dn = ex + 1.0f; f32x4 rc;
#pragma unroll
                    for (int e = 0; e < 4; ++e) rc[e] = __builtin_amdgcn_rcpf(dn[e]);
                    hv[n] = (g * up) * rc; }
                __builtin_nontemporal_store(pack8(hv[0], hv[1]), (u32x4*)(H + (size_t)row * 2816 + col0)); }
    }
};
template <bool BASE_B, bool WRITE_B, bool WRITE_F, int SCALE2> struct EpiRes {
    static constexpr bool PERM = true, AFTER_DRAIN = false, CHAIN = false, ROWSTAT = false;
    const float* basef; float* outf; bf16_t* XB; float* ssn;
    __device__ __forceinline__ void operator()(const f32x4 (&acc)[2][2][4][2], const Unit& u, int wr, int wc, int fr, int fq) const {
        const int row0 = u.pm * BM + wr * 64 + fr, col0 = u.pn * BM + wc * 32 + 8 * fq; constexpr float scale = 0.5f * SCALE2;
        u32x4 bw[2][4][2]; f32x4 bf0[2][4][2], bf1[2][4][2];
#define EPIRES_LOAD(ai) do { _Pragma("unroll") for (int m = 0; m < 4; ++m) _Pragma("unroll") for (int bj = 0; bj < 2; ++bj) { const size_t off = (size_t)(row0 + (ai) * HALF + m * 16) * 1024 + col0 + bj * HALF; \
            if (BASE_B) bw[ai][m][bj] = *(const u32x4*)(XB + off); else { bf0[ai][m][bj] = *(const f32x4*)(basef + off); bf1[ai][m][bj] = *(const f32x4*)(basef + off + 4); } } } while (0)
#define EPIRES_COMP(ai) do { _Pragma("unroll") for (int m = 0; m < 4; ++m) { float sq = 0.f; \
            _Pragma("unroll") for (int bj = 0; bj < 2; ++bj) { f32x4 b0, b1; \
                if (BASE_B) { const u32x4 w_ = bw[ai][m][bj]; b0 = (f32x4){bf_lo(w_.x), bf_hi(w_.x), bf_lo(w_.y), bf_hi(w_.y)}; b1 = (f32x4){bf_lo(w_.z), bf_hi(w_.z), bf_lo(w_.w), bf_hi(w_.w)}; } \
                else { b0 = bf0[ai][m][bj]; b1 = bf1[ai][m][bj]; } \
                const f32x4 o0 = b0 + acc[ai][bj][m][0] * scale, o1 = b1 + acc[ai][bj][m][1] * scale; ov0[m][bj] = o0; ov1[m][bj] = o1; \
                if (WRITE_B) sq += (o0[0] * o0[0] + o0[1] * o0[1]) + (o0[2] * o0[2] + o0[3] * o0[3]) + (o1[0] * o1[0] + o1[1] * o1[1]) + (o1[2] * o1[2] + o1[3] * o1[3]); } \
            if (WRITE_B) { sq += __shfl_xor(sq, 16); sq += __shfl_xor(sq, 32); } sqv[m] = sq; } } while (0)
#define EPIRES_STORE(ai) do { _Pragma("unroll") for (int m = 0; m < 4; ++m) { const int row = row0 + (ai) * HALF + m * 16; \
            _Pragma("unroll") for (int bj = 0; bj < 2; ++bj) { const size_t off = (size_t)row * 1024 + col0 + bj * HALF; \
                if (WRITE_F) { __builtin_nontemporal_store(ov0[m][bj], (f32x4*)(outf + off)); __builtin_nontemporal_store(ov1[m][bj], (f32x4*)(outf + off + 4)); } \
                if (WRITE_B) *(u32x4*)(XB + off) = pack8(ov0[m][bj], ov1[m][bj]); } \
            if (WRITE_B) { if (fq == 0) ssn[(size_t)row * 16 + u.pn * 4 + wc] = sqv[m]; } } } while (0)
        f32x4 ov0[4][2], ov1[4][2]; float sqv[4];
        EPIRES_LOAD(0); __builtin_amdgcn_sched_barrier(0);
        if (BASE_B) { EPIRES_LOAD(1); __builtin_amdgcn_sched_barrier(0); }
        EPIRES_COMP(0); __builtin_amdgcn_sched_barrier(0);
        if (!BASE_B) { EPIRES_LOAD(1); __builtin_amdgcn_sched_barrier(0); }
        EPIRES_STORE(0); __builtin_amdgcn_sched_barrier(0);
        EPIRES_COMP(1); __builtin_amdgcn_sched_barrier(0);
        EPIRES_STORE(1);
#undef EPIRES_LOAD
#undef EPIRES_COMP
#undef EPIRES_STORE
    }
};
struct EpiBranch {
    static constexpr bool PERM = true, AFTER_DRAIN = false, CHAIN = true, ROWSTAT = false;
    const bf16_t* GA; const bf16_t* GB; bf16_t* MG;
    __device__ __forceinline__ void operator()(f32x4 (&acc)[2][2][4][2], const Unit& u, int wr, int wc, int fr, int fq) const {
        const int row0 = u.pm * BM + wr * 64 + fr, col0 = u.pn * BM + wc * 32 + 8 * fq; const bf16_t* G = u.sel ? GB : GA;
        u32x4 gwv[2][4][2];
#pragma unroll
        for (int ai = 0; ai < 2; ++ai)
#pragma unroll
            for (int m = 0; m < 4; ++m)
#pragma unroll
                for (int bj = 0; bj < 2; ++bj) gwv[ai][m][bj] = *(const u32x4*)(G + (size_t)(row0 + ai * HALF + m * 16) * 1024 + col0 + bj * HALF);
        __builtin_amdgcn_sched_barrier(0);
#pragma unroll
        for (int ai = 0; ai < 2; ++ai)
#pragma unroll
            for (int m = 0; m < 4; ++m) { const size_t off = (size_t)(row0 + ai * HALF + m * 16) * 1024 + col0;
#pragma unroll
                for (int bj = 0; bj < 2; ++bj) { const u32x4 gw = gwv[ai][m][bj];
                    f32x4 v0 = acc[ai][bj][m][0], v1 = acc[ai][bj][m][1];
                    v0[0] *= bf_lo(gw.x); v0[1] *= bf_hi(gw.x); v0[2] *= bf_lo(gw.y); v0[3] *= bf_hi(gw.y); v1[0] *= bf_lo(gw.z); v1[1] *= bf_hi(gw.z); v1[2] *= bf_lo(gw.w); v1[3] *= bf_hi(gw.w);
                    if (u.sel) *(u32x4*)(MG + off + bj * HALF) = pack8(v0, v1);
                    else { acc[ai][bj][m][0] = v0; acc[ai][bj][m][1] = v1; } } }
    }
};
struct EpiWin {
    static constexpr bool PERM = true, AFTER_DRAIN = false, CHAIN = false, ROWSTAT = true;
    const float* ss; bf16_t *FQ, *FK, *FV, *DQ, *DK, *DV, *IQ, *IK, *GA, *GB; float* LOGF2; float* IWS;
    const float* bforget; PG8_LAS unsigned char* lds;
    __device__ __forceinline__ void operator()(const f32x4 (&acc)[2][2][4][2], const Unit& u, int wr, int wc, int fr, int fq) const {
        const int g = u.pn * 4 + wc; const int row0 = u.pm * BM + wr * 64 + fr;
        if (g == 43) {
#pragma unroll
            for (int ai = 0; ai < 2; ++ai)
#pragma unroll
                for (int m = 0; m < 4; ++m) { const int row = row0 + ai * HALF + m * 16; const float rs = rstd_lds(lds, u.par, wr * 64 + fr + ai * HALF + m * 16);
                    const f32x4 v0 = acc[ai][0][m][0] * rs, v1 = acc[ai][0][m][1] * rs;
                    if (fq == 0) { const int b = row >> 11, s = row & 2047;
#pragma unroll
                        for (int e = 0; e < 8; ++e) { const float z = (e < 4 ? v0[e & 3] : v1[e & 3]) + *(const PG8_LAS float*)(lds + BF_LDS + 4 * e);
                            const float t = __builtin_amdgcn_exp2f(-__builtin_fabsf(z) * LOG2E);
                            LOGF2[(size_t)(b * 8 + e) * SEQ + s] = __builtin_fminf(z, 0.f) * LOG2E - __builtin_amdgcn_logf(1.0f + t); } }
                    else if (fq == 1) { const float sc = 0.35355339059327373f * 0.125f;
                        *(f32x4*)(IWS + (size_t)row * 8) = v0 * sc; *(f32x4*)(IWS + (size_t)row * 8 + 4) = v1 * sc; } }
            return;
        }
        if (g >= 44) {
            const int cbg = (g - 44) * 32 + 8 * fq;
#pragma unroll
            for (int ai = 0; ai < 2; ++ai)
#pragma unroll
                for (int m = 0; m < 4; ++m) { const int row = row0 + ai * HALF + m * 16; const float rs = rstd_lds(lds, u.par, wr * 64 + fr + ai * HALF + m * 16);
                    f32x4 rr[2], sb[2];
#pragma unroll
                    for (int n = 0; n < 2; ++n)
#pragma unroll
                        for (int e = 0; e < 4; ++e) { float za = acc[ai][0][m][n][e] * rs, zb = acc[ai][1][m][n][e] * rs;
                            za = __builtin_fminf(__builtin_fmaxf(za, -30.f), 30.f); zb = __builtin_fminf(__builtin_fmaxf(zb, -30.f), 30.f);
                            const float ea = __builtin_amdgcn_exp2f(-1.4426950408889634f * za), eb = __builtin_amdgcn_exp2f(-1.4426950408889634f * zb);
                            sb[n][e] = __builtin_amdgcn_rcpf(1.0f + eb); rr[n][e] = (1.0f + eb) * __builtin_amdgcn_rcpf(1.0f + ea); }
                    __builtin_nontemporal_store(pack8(rr[0], rr[1]), (u32x4*)(GA + (size_t)row * 1024 + cbg)); __builtin_nontemporal_store(pack8(sb[0], sb[1]), (u32x4*)(GB + (size_t)row * 1024 + cbg)); }
            return;
        }
        int mode; bf16_t* dst; int pitch, cb; int gain = 0; float osc = 1.f;
        if (g < 8)       { mode = 1; dst = FQ; pitch = 512; cb = g * 64; gain = 0; osc = C2; }
        else if (g < 16) { mode = 1; dst = FK; pitch = 512; cb = (g - 8) * 64; gain = 1; }
        else if (g < 24) { mode = 0; dst = FV; pitch = 512; cb = (g - 16) * 64; }
        else if (g < 32) { mode = 1; dst = DQ; pitch = 512; cb = (g - 24) * 64; gain = 2; osc = C2; }
        else if (g == 32) { mode = 1; dst = DK; pitch = 64; cb = 0; gain = 3; }
        else if (g == 33) { mode = 0; dst = DV; pitch = 64; cb = 0; }
        else if (g < 42) { mode = 0; dst = IQ; pitch = 512; cb = (g - 34) * 64; }
        else             { mode = 0; dst = IK; pitch = 64; cb = 0; }
        f32x4 gv[2][2];
#pragma unroll
        for (int bj = 0; bj < 2; ++bj)
#pragma unroll
            for (int n = 0; n < 2; ++n) gv[bj][n] = (mode == 1) ? *(const PG8_LAS f32x4*)(lds + GAIN_LDS + 4 * (gain * 64 + 32 * bj + 8 * fq + 4 * n)) : (f32x4){1.f, 1.f, 1.f, 1.f};
#pragma unroll
        for (int ai = 0; ai < 2; ++ai)
#pragma unroll
            for (int m = 0; m < 4; ++m) { const int row = row0 + ai * HALF + m * 16; const float rs = rstd_lds(lds, u.par, wr * 64 + fr + ai * HALF + m * 16);
                f32x4 v[2][2]; float sq = 0.f;
#pragma unroll
                for (int bj = 0; bj < 2; ++bj)
#pragma unroll
                    for (int n = 0; n < 2; ++n) { v[bj][n] = acc[ai][bj][m][n] * rs; const f32x4 t = v[bj][n]; sq += (t[0] * t[0] + t[1] * t[1]) + (t[2] * t[2] + t[3] * t[3]); }
                if (mode == 1) { sq += __shfl_xor(sq, 16); sq += __shfl_xor(sq, 32); const float r = __builtin_amdgcn_rsqf(sq * (1.0f / 64.0f) + 1e-6f) * osc;
#pragma unroll
                    for (int bj = 0; bj < 2; ++bj)
#pragma unroll
                        for (int n = 0; n < 2; ++n) v[bj][n] = v[bj][n] * r * gv[bj][n]; }
                bf16_t* rowp = dst + (size_t)row * pitch + cb + 8 * fq;
#pragma unroll
                for (int bj = 0; bj < 2; ++bj) *(u32x4*)(rowp + 32 * bj) = pack8(v[bj][0], v[bj][1]); }
    }
};

template <class Epi, class Sched, bool ALIGN_EPI = false, bool SP2 = false>
__device__ __forceinline__ void gemm_phase(PG8_LAS unsigned char* lds, const Gemm g, const Sched& S, const Epi& E, const int wid, const int lane) {
    const int tid = wid * 64 + lane, wr = wid >> 2, wc = wid & 3, fr = lane & 15, fq = lane >> 4;
    const int K = g.K, nt = K / BK;
    unsigned voffA[2], voffB[2];
#pragma unroll
    for (int i = 0; i < 2; ++i) { int R, C; stage_rc(tid * 16 + i * 8192, R, C); const int Rb = Epi::PERM ? ((R & ~31) + perm32(R & 31)) : R;
        voffA[i] = (unsigned)(R * K + C) * 2u; voffB[i] = (unsigned)(Rb * K + C) * 2u; }
    const size_t kstep = (size_t)(BK * 2);
    const size_t hstep = (size_t)HALF * K * 2;
    const size_t tstep = 2 * hstep;
    const unsigned ldsw = (unsigned)wid * 1024u;
    const int aoff = lds_byte(wr * 64 + fr, fq * 8), boff = lds_byte(wc * 32 + fr, fq * 8);
#define PG8_SA(b, h) (((b) * 2 + (h)) * HTB)
#define PG8_SB(b, h) ((4 + (b) * 2 + (h)) * HTB)
#define PG8_STAGE(bufoff, gbase, voff) do { _Pragma("unroll") for (int _i = 0; _i < 2; ++_i) \
        __builtin_amdgcn_global_load_lds((const unsigned*)((const char*)(gbase) + (voff)[_i]), (PG8_LAS unsigned*)(lds + (bufoff) + ldsw + _i * 8192), 16, 0, 0); } while (0)
#define PG8_LDA(dst, b, h) do { _Pragma("unroll") for (int m = 0; m < 4; ++m) _Pragma("unroll") for (int k = 0; k < 2; ++k) dst[m][k] = *(const PG8_LAS bf16x8*)(lds + PG8_SA(b, h) + aoff + m * 2048 + k * 1024); } while (0)
#define PG8_LDB(dst, b, h) do { _Pragma("unroll") for (int n = 0; n < 2; ++n) _Pragma("unroll") for (int k = 0; k < 2; ++k) dst[n][k] = *(const PG8_LAS bf16x8*)(lds + PG8_SB(b, h) + boff + n * 2048 + k * 1024); } while (0)
#define PG8_MMA(ai, bj, At, Bt) do { __builtin_amdgcn_s_setprio(1); _Pragma("unroll") for (int m = 0; m < 4; ++m) _Pragma("unroll") for (int n = 0; n < 2; ++n) _Pragma("unroll") for (int k = 0; k < 2; ++k) \
        acc[ai][bj][m][n] = __builtin_amdgcn_mfma_f32_16x16x32_bf16(Bt[n][k], At[m][k], acc[ai][bj][m][n], 0, 0, 0); __builtin_amdgcn_s_setprio(0); } while (0)
#define PG8_WAIT_V(n) asm volatile("s_waitcnt vmcnt(" #n ")" ::: "memory")
#define PG8_WAIT_L(n) asm volatile("s_waitcnt lgkmcnt(" #n ")" ::: "memory")
#define PG8_BAR __builtin_amdgcn_s_barrier()
#define PG8_SCHED __builtin_amdgcn_sched_barrier(0)
    Unit cur, nxt; int ui = 0;
    if (!S.next(0, cur)) return;
    f32x4 acc[2][2][4][2];
#pragma unroll
    for (int a = 0; a < 2; ++a)
#pragma unroll
        for (int b = 0; b < 2; ++b)
#pragma unroll
            for (int m = 0; m < 4; ++m)
#pragma unroll
                for (int n = 0; n < 2; ++n) acc[a][b][m][n] = (f32x4){0.f, 0.f, 0.f, 0.f};
    bf16x8 At[4][2], B0[2][2], B1[2][2];
    const char* cA = (const char*)(cur.sel ? g.A2 : g.A) + (size_t)cur.pm * tstep; const char* cB = (const char*)(cur.sel ? g.Bt2 : g.Bt) + (size_t)cur.pn * tstep;
    S.a_ready(cur);
    if constexpr (Epi::ROWSTAT) rowstat_dma(E.ss, cur.pm, lds, wid, lane);
    if constexpr (SP2) {
        PG8_STAGE(PG8_SB(0, 0), cB, voffB); PG8_STAGE(PG8_SB(0, 1), cB + hstep, voffB); PG8_STAGE(PG8_SA(0, 0), cA, voffA); PG8_STAGE(PG8_SA(0, 1), cA + hstep, voffA);
        if (wr == 1) PG8_BAR;
        PG8_WAIT_V(2); PG8_BAR;
        PG8_STAGE(PG8_SB(1, 0), cB + kstep, voffB); PG8_STAGE(PG8_SA(1, 0), cA + kstep, voffA); PG8_STAGE(PG8_SB(1, 1), cB + hstep + kstep, voffB);
        PG8_WAIT_V(6); PG8_BAR;
    } else {
        PG8_STAGE(PG8_SB(0, 0), cB, voffB); PG8_STAGE(PG8_SA(0, 0), cA, voffA); PG8_STAGE(PG8_SB(0, 1), cB + hstep, voffB); PG8_STAGE(PG8_SA(0, 1), cA + hstep, voffA);
        if (wr == 1) PG8_BAR;
        PG8_WAIT_V(4); PG8_BAR;
        PG8_STAGE(PG8_SB(1, 0), cB + kstep, voffB); PG8_STAGE(PG8_SA(1, 0), cA + kstep, voffA); PG8_STAGE(PG8_SB(1, 1), cB + hstep + kstep, voffB);
        PG8_WAIT_V(6); PG8_BAR;
    }
    if constexpr (Epi::ROWSTAT) rowstat_fold(lds, 0, tid);
    for (;;) {
        const bool has_next = S.next(ui + 1, nxt);
        const char* nA = has_next ? (const char*)(nxt.sel ? g.A2 : g.A) + (size_t)nxt.pm * tstep : cA; const char* nB = has_next ? (const char*)(nxt.sel ? g.Bt2 : g.Bt) + (size_t)nxt.pn * tstep : cB;
        for (int t = 0; t < nt; t += 2) {
            const bool last = (t == nt - 2);
            const char* a1 = cA + (size_t)(t + 1) * kstep;
            const char* a2 = last ? nA : cA + (size_t)(t + 2) * kstep; const char* b2 = last ? nB : cB + (size_t)(t + 2) * kstep;
            const char* a3 = a2 + kstep; const char* b3 = b2 + kstep;
            if (last && has_next) { S.a_ready(nxt); if constexpr (Epi::ROWSTAT) rowstat_dma(E.ss, nxt.pm, lds, wid, lane); }
            if constexpr (SP2) {
            PG8_LDB(B0, 0, 0); PG8_LDB(B1, 0, 1); PG8_SCHED; PG8_LDA(At, 0, 0); PG8_STAGE(PG8_SA(1, 1), a1 + hstep, voffA);
            PG8_WAIT_V(8); PG8_WAIT_L(0); PG8_BAR; PG8_MMA(0, 0, At, B0); PG8_MMA(0, 1, At, B1); PG8_BAR; PG8_SCHED;
            PG8_LDA(At, 0, 1); PG8_STAGE(PG8_SB(0, 0), b2, voffB); PG8_STAGE(PG8_SB(0, 1), b2 + hstep, voffB); PG8_STAGE(PG8_SA(0, 0), a2, voffA);
            PG8_WAIT_V(8); PG8_WAIT_L(0); PG8_BAR; PG8_MMA(1, 0, At, B0); PG8_MMA(1, 1, At, B1); PG8_BAR; PG8_SCHED;
            PG8_LDB(B0, 1, 0); PG8_LDB(B1, 1, 1); PG8_SCHED; PG8_LDA(At, 1, 0); PG8_STAGE(PG8_SA(0, 1), a2 + hstep, voffA);
            PG8_WAIT_V(8); PG8_WAIT_L(0); PG8_BAR; PG8_MMA(0, 0, At, B0); PG8_MMA(0, 1, At, B1); PG8_BAR; PG8_SCHED;
            PG8_LDA(At, 1, 1); PG8_STAGE(PG8_SB(1, 0), b3, voffB); PG8_STAGE(PG8_SB(1, 1), b3 + hstep, voffB); PG8_STAGE(PG8_SA(1, 0), a3, voffA);
            PG8_WAIT_V(8); PG8_WAIT_L(0); PG8_BAR; PG8_MMA(1, 0, At, B0); PG8_MMA(1, 1, At, B1); PG8_BAR; PG8_SCHED;
            } else {
            PG8_LDB(B0, 0, 0); PG8_SCHED; PG8_LDA(At, 0, 0); PG8_STAGE(PG8_SA(1, 1), a1 + hstep, voffA);
            PG8_WAIT_L(8); PG8_BAR; PG8_WAIT_L(0); PG8_MMA(0, 0, At, B0); PG8_BAR; PG8_SCHED;
            PG8_LDB(B1, 0, 1); PG8_STAGE(PG8_SB(0, 0), b2, voffB);
            PG8_BAR; PG8_WAIT_L(0); PG8_MMA(0, 1, At, B1); PG8_BAR;
            PG8_LDA(At, 0, 1); PG8_STAGE(PG8_SA(0, 0), a2, voffA);
            PG8_BAR; PG8_WAIT_L(0); PG8_MMA(1, 0, At, B0); PG8_BAR; PG8_SCHED;
            PG8_STAGE(PG8_SB(0, 1), b2 + hstep, voffB);
            PG8_WAIT_V(6); PG8_BAR; PG8_MMA(1, 1, At, B1); PG8_BAR;
            PG8_LDB(B0, 1, 0); PG8_SCHED; PG8_LDA(At, 1, 0); PG8_STAGE(PG8_SA(0, 1), a2 + hstep, voffA);
            PG8_WAIT_L(8); PG8_BAR; PG8_WAIT_L(0); PG8_MMA(0, 0, At, B0); PG8_BAR; PG8_SCHED;
            PG8_LDB(B1, 1, 1); PG8_STAGE(PG8_SB(1, 0), b3, voffB);
            PG8_BAR; PG8_WAIT_L(0); PG8_MMA(0, 1, At, B1); PG8_BAR;
            PG8_LDA(At, 1, 1); PG8_STAGE(PG8_SA(1, 0), a3, voffA);
            PG8_BAR; PG8_WAIT_L(0); PG8_MMA(1, 0, At, B0); PG8_BAR; PG8_SCHED;
            PG8_STAGE(PG8_SB(1, 1), b3 + hstep, voffB);
            PG8_WAIT_V(6); PG8_BAR; PG8_MMA(1, 1, At, B1); PG8_BAR;
            }
        }
        if constexpr (ALIGN_EPI) { if (wr == 0) PG8_BAR; }
        cur.par = ui & 1;
        if constexpr (!Epi::AFTER_DRAIN) { E(acc, cur, wr, wc, fr, fq); S.done(cur); }
        if (!has_next) break;
        if constexpr (Epi::ROWSTAT) rowstat_fold(lds, (ui + 1) & 1, tid);
        if (!(Epi::CHAIN && cur.sel == 0)) {
#pragma unroll
        for (int a = 0; a < 2; ++a)
#pragma unroll
            for (int b = 0; b < 2; ++b)
#pragma unroll
                for (int m = 0; m < 4; ++m)
#pragma unroll
                    for (int n = 0; n < 2; ++n) acc[a][b][m][n] = (f32x4){0.f, 0.f, 0.f, 0.f};
        }
        cur = nxt; cA = nA; cB = nB; ++ui;
        if constexpr (ALIGN_EPI) { if (wr == 1) PG8_BAR; }
    }
    PG8_WAIT_V(0);
    if constexpr (!ALIGN_EPI) { if (wr == 0) PG8_BAR; }
    PG8_BAR;
    if constexpr (Epi::AFTER_DRAIN) { E.fused(acc, cur, wr, wc, fr, fq, lds, wid, lane); S.done(cur); }
#undef PG8_SA
#undef PG8_SB
#undef PG8_STAGE
#undef PG8_LDA
#undef PG8_LDB
#undef PG8_MMA
#undef PG8_WAIT_V
#undef PG8_WAIT_L
#undef PG8_BAR
#undef PG8_SCHED
}
}

constexpr int NWAVES = 8, NTHREADS = NWAVES * 64;
constexpr int NPHASE = 10;
constexpr int N_LAUNCHES = MK_N_LAUNCHES;
constexpr size_t MiB = 1u << 20, KiB = 1u << 10;
constexpr size_t WS_CTL = 0, CTL_ZERO_BYTES = 64 * KiB;
constexpr size_t WS_WGU1 = 1 * MiB, WS_WD1 = 12 * MiB, WS_WIN = 17 * MiB + 512 * KiB, WS_WA = 27 * MiB, WS_WB = 28 * MiB, WS_WOUT = 29 * MiB, WS_WGU2 = 31 * MiB, WS_WD2 = 42 * MiB;
constexpr size_t WS_XB = 48 * MiB;
constexpr size_t WS_SS = 488 * MiB;
constexpr size_t WS_LOGF = 112 * MiB + 512 * KiB, WS_CUM = 113 * MiB + 512 * KiB, WS_IW = 114 * MiB + 512 * KiB;
constexpr size_t WS_SEL = 116 * MiB;
constexpr size_t WS_FQ = 124 * MiB, WS_DQ = 156 * MiB, WS_FK = 188 * MiB, WS_FV = 220 * MiB, WS_IQ = 252 * MiB, WS_DK = 284 * MiB, WS_DV = 288 * MiB, WS_IK = 292 * MiB, WS_GA = 296 * MiB, WS_GB = 360 * MiB;
constexpr size_t WS_H = 124 * MiB;
constexpr size_t WS_MG = 424 * MiB, WS_END = 494 * MiB;
static_assert(WS_H + (size_t)TOK * DFF * 2 <= WS_MG && WS_GB + (size_t)TOK * DM * 2 <= WS_MG && WS_XB + (size_t)TOK * DM * 2 <= WS_LOGF && WS_SS + (size_t)3 * TOK * 64 <= WS_END, "ws map");
constexpr int CW_BAR = 4096;
constexpr int RING_BYTES = 131072, LDSCTL_OFF = RING_BYTES, MISC_OFF = LDSCTL_OFF + 320, LDS_BYTES = 155648;

#define GAS __attribute__((address_space(1)))
#define LAS __attribute__((address_space(3)))
typedef unsigned short bf16;
typedef unsigned v4u __attribute__((ext_vector_type(4)));
typedef unsigned v2u __attribute__((ext_vector_type(2)));
typedef float f32x4 __attribute__((ext_vector_type(4)));
typedef float f32x16 __attribute__((ext_vector_type(16)));
typedef short bf16x8 __attribute__((ext_vector_type(8)));
typedef short s16x4 __attribute__((ext_vector_type(4)));
typedef GAS unsigned gu32;
#define RLX_AGENT __ATOMIC_RELAXED, __HIP_MEMORY_SCOPE_AGENT
#define LDS_WAIT() asm volatile("s_waitcnt lgkmcnt(0)" ::: "memory")
#define VM_WAIT() asm volatile("s_waitcnt vmcnt(0)" ::: "memory")
__device__ __forceinline__ unsigned pkbf(float lo, float hi) { return pg8::cvt_pk_bf16(lo, hi); }

#define XB_TMO      128
#define XB_XCNT(j)  (256  + 64 * (j))
#define XB_XSUB(j)  (1280 + 64 * (j))
#define XB_XGEN(j)  (2304 + 64 * (j))
#define XB_TOP      3328
#define XB_TOPGEN   3392
#define XCD_BAR_WORDS 3456
#define XB_SPIN_CAP (1u << 20)
__device__ __forceinline__ unsigned xb_ld(unsigned* p)              { return __hip_atomic_load(p, __ATOMIC_RELAXED, __HIP_MEMORY_SCOPE_AGENT); }
__device__ __forceinline__ unsigned xb_add(unsigned* p, unsigned v) { return __hip_atomic_fetch_add(p, v, __ATOMIC_RELAXED, __HIP_MEMORY_SCOPE_AGENT); }
__device__ __forceinline__ unsigned xb_xcc_id() { return (unsigned)__builtin_amdgcn_s_getreg((3 << 11) | 20) & 0xFu; }
#define XB_SPIN(cond, bar) do { unsigned _sp = 0; while (cond) { __builtin_amdgcn_s_sleep(1); \
    if ((++_sp & 255u) == 0u) { if (xb_ld(&(bar)[XB_TMO])) break; if (_sp > XB_SPIN_CAP) { atomicAdd(&(bar)[XB_TMO], 1u); break; } } } } while (0)
__device__ __forceinline__ int fresh_lane() { int l; asm volatile("v_mbcnt_lo_u32_b32 %0, -1, 0\n\tv_mbcnt_hi_u32_b32 %0, -1, %0" : "=v"(l)); return l; }
struct XcdBarrier { unsigned* bar; unsigned x; volatile LAS unsigned* st; };
__device__ __forceinline__ XcdBarrier xcd_barrier_post(unsigned* bar, volatile LAS unsigned* st, bool t0) {
    XcdBarrier b; b.bar = bar; b.x = xb_xcc_id(); b.st = st;
    if (t0) (void)xb_add(&bar[XB_XCNT(b.x)], 1u);
    return b;
}
__device__ __forceinline__ void xcd_barrier_complete(unsigned* bar, unsigned x, unsigned& nloc, unsigned& nx) {
    const unsigned G = gridDim.x * gridDim.y * gridDim.z;
    unsigned sum, cnt, mine, sp = 0u;
    for (;;) {
        sum = 0u; cnt = 0u; mine = 0u;
#pragma unroll
        for (unsigned j = 0; j < 16; ++j) { const unsigned c = xb_ld(&bar[XB_XCNT(j)]); sum += c; cnt += (c > 0u) ? 1u : 0u; mine = (j == x) ? c : mine; }
        if (sum == G) break;
        __builtin_amdgcn_s_sleep(1);
        if ((++sp & 255u) == 0u) { if (xb_ld(&bar[XB_TMO])) break; if (sp > XB_SPIN_CAP) { atomicAdd(&bar[XB_TMO], 1u); break; } }
    }
    nloc = mine > 0u ? mine : 1u; nx = cnt > 0u ? cnt : 1u;
}
__device__ __forceinline__ void xcd_barrier(const XcdBarrier& b, bool t0) {
    asm volatile("s_waitcnt vmcnt(0)" ::: "memory");
    __syncthreads();
    if (t0) {
        unsigned* bar = b.bar;
        __builtin_amdgcn_s_waitcnt(0);
        unsigned nloc = b.st[0], nx = b.st[1];
        if (nloc == 0u) { xcd_barrier_complete(bar, b.x, nloc, nx); b.st[0] = nloc; b.st[1] = nx; }
        const unsigned old = xb_add(&bar[XB_XSUB(b.x)], 1u);
        const unsigned gen = old / nloc;
        if (old + 1u == (gen + 1u) * nloc) {
            __builtin_amdgcn_fence(__ATOMIC_RELEASE, "agent");
            asm volatile("s_waitcnt vmcnt(0)" ::: "memory");
            const unsigned og = xb_add(&bar[XB_TOP], 1u);
            const unsigned tg = og / nx;
            if (og + 1u == (tg + 1u) * nx) xb_add(&bar[XB_TOPGEN], 1u);
            else XB_SPIN(xb_ld(&bar[XB_TOPGEN]) == tg, bar);
            __builtin_amdgcn_fence(__ATOMIC_ACQUIRE, "agent");
            xb_add(&bar[XB_XGEN(b.x)], 1u);
            asm volatile("s_waitcnt vmcnt(0)" ::: "memory");
        } else {
            XB_SPIN(xb_ld(&bar[XB_XGEN(b.x)]) == gen, bar);
            __builtin_amdgcn_fence(__ATOMIC_ACQUIRE, "agent");
            asm volatile("s_waitcnt vmcnt(0)" ::: "memory");
        }
    }
    __syncthreads();
}

__device__ __forceinline__ float wave_sum(float v) {
#pragma unroll
    for (int o = 1; o < 64; o <<= 1) v += __shfl_xor(v, o);
    return v;
}
struct MapIdent { __device__ __forceinline__ int operator()(int c) const { return c; } };
struct MapGU { int up; __device__ __forceinline__ int operator()(int c) const { return (c >> 7) * 256 + up * 128 + (c & 127); } };
struct MapWin { __device__ __forceinline__ int operator()(int c) const {
    int g, d;
    if (c < 1536) { g = c >> 6; d = c & 63; }
    else if (c < 1544) { g = 43; d = c - 1536; }
    else if (c < 2056) { const int e = c - 1544; g = 24 + (e >> 6); d = e & 63; }
    else if (c < 2184) { const int e = c - 2056; g = 32 + (e >> 6); d = e & 63; }
    else if (c < 2696) { const int e = c - 2184; g = 34 + (e >> 6); d = e & 63; }
    else if (c < 2760) { g = 42; d = c - 2696; }
    else if (c < 2768) { g = 43; d = 8 + (c - 2760); }
    else if (c < 3792) { const int e = c - 2768; g = 44 + (e >> 5); d = e & 31; }
    else { const int e = c - 3792; g = 44 + (e >> 5); d = 32 + (e & 31); }
    return (g >> 2) * 256 + (d >> 5) * 128 + (g & 3) * 32 + (d & 31); } };
template <class Map>
__device__ __forceinline__ void p0_transpose_item(const float* W, int K, int N, const float* gain, bf16* WT, const Map map, LAS float* scr, int item, int lane) {
    const int nblk = (N + 31) / 32, kb = item / nblk, nb = item % nblk, k0 = 64 * kb, n0 = 32 * nb;
    const int c4 = (lane & 7) * 4, nc = n0 + c4; const bool ok = nc < N;
#pragma unroll
    for (int i = 0; i < 8; ++i) { const int kk = 8 * i + (lane >> 3);
        const f32x4 v = ok ? __builtin_nontemporal_load((const f32x4*)(W + (size_t)(k0 + kk) * N + nc)) : (f32x4){0.f, 0.f, 0.f, 0.f};
        LAS float* sp = scr + kk * 33 + c4; sp[0] = v[0]; sp[1] = v[1]; sp[2] = v[2]; sp[3] = v[3]; }
    LDS_WAIT(); asm volatile("" ::: "memory");
    const int c = lane & 7;
    f32x4 g0 = (f32x4){1.f, 1.f, 1.f, 1.f}, g1 = g0;
    if (gain) { g0 = *(const f32x4*)(gain + k0 + 8 * c); g1 = *(const f32x4*)(gain + k0 + 8 * c + 4); }
#pragma unroll
    for (int j = 0; j < 4; ++j) { const int n = (lane >> 3) + 8 * j; const LAS float* s = scr + (8 * c) * 33 + n;
        if (n0 + n < N) { v4u o; o.x = pkbf(s[0 * 33] * g0[0], s[1 * 33] * g0[1]); o.y = pkbf(s[2 * 33] * g0[2], s[3 * 33] * g0[3]); o.z = pkbf(s[4 * 33] * g1[0], s[5 * 33] * g1[1]); o.w = pkbf(s[6 * 33] * g1[2], s[7 * 33] * g1[3]);
            *(GAS v4u*)(WT + (size_t)map(n0 + n) * K + k0 + 8 * c) = o; } }
    LDS_WAIT(); asm volatile("" ::: "memory");
}
struct P0Args { const float *x, *n1, *wg1, *wu1, *wd1, *nm, *win, *wa, *wb, *wout, *n2, *wg2, *wu2, *wd2; bf16 *Wgu1, *Wd1, *Win, *Wa, *Wb, *Wout, *Wgu2, *Wd2, *XB; float* SS; };
__device__ __forceinline__ void p0_prologue(const P0Args& a, LAS unsigned char* lds, int vcu, int G, int wave, int lane) {
    LAS float* scr = (LAS float*)(lds + wave * 16384);
    const int gw = vcu * NWAVES + wave, NGW = G * NWAVES;
    constexpr int I_GU = (DM / 64) * (DFF / 32), I_D = (DFF / 64) * (DM / 32), I_IN = (DM / 64) * ((IN_W + 31) / 32), I_BR = (HW / 64) * (DM / 32), I_O = (DM / 64) * (DM / 32);
    constexpr int NITEMS = 6 * I_GU + I_IN + 2 * I_BR + I_O;
    static_assert(I_GU == I_D, "items");
    for (int it = gw; it < NITEMS; it += NGW) {
        int r = it;
        if (r < I_GU) { p0_transpose_item(a.wg1, DM, DFF, a.n1, a.Wgu1, MapGU{0}, scr, r, lane); continue; } r -= I_GU;
        if (r < I_GU) { p0_transpose_item(a.wu1, DM, DFF, a.n1, a.Wgu1, MapGU{1}, scr, r, lane); continue; } r -= I_GU;
        if (r < I_D)  { p0_transpose_item(a.wd1, DFF, DM, nullptr, a.Wd1, MapIdent{}, scr, r, lane); continue; } r -= I_D;
        if (r < I_GU) { p0_transpose_item(a.wg2, DM, DFF, a.n2, a.Wgu2, MapGU{0}, scr, r, lane); continue; } r -= I_GU;
        if (r < I_GU) { p0_transpose_item(a.wu2, DM, DFF, a.n2, a.Wgu2, MapGU{1}, scr, r, lane); continue; } r -= I_GU;
        if (r < I_D)  { p0_transpose_item(a.wd2, DFF, DM, nullptr, a.Wd2, MapIdent{}, scr, r, lane); continue; } r -= I_D;
        if (r < I_IN) { p0_transpose_item(a.win, DM, IN_W, a.nm, a.Win, MapWin{}, scr, r, lane); continue; } r -= I_IN;
        if (r < I_BR) { p0_transpose_item(a.wa, HW, DM, nullptr, a.Wa, MapIdent{}, scr, r, lane); continue; } r -= I_BR;
        if (r < I_BR) { p0_transpose_item(a.wb, HW, DM, nullptr, a.Wb, MapIdent{}, scr, r, lane); continue; } r -= I_BR;
        p0_transpose_item(a.wout, DM, DM, nullptr, a.Wout, MapIdent{}, scr, r, lane);
    }
    for (int i = gw; i < 48; i += NGW) { const int d = 16 + i, row = 10 * 256 + (d >> 5) * 128 + 96 + (d & 31);
        GAS v4u* p = (GAS v4u*)(a.Win + (size_t)row * DM) + lane; p[0] = (v4u){0u, 0u, 0u, 0u}; p[64] = (v4u){0u, 0u, 0u, 0u}; }
    for (int m = gw; m < TOK; m += NGW) {
        const GAS f32x4* xr = (const GAS f32x4*)(a.x + (size_t)m * DM) + lane; f32x4 v[4]; float s = 0.f;
#pragma unroll
        for (int j = 0; j < 4; ++j) { v[j] = __builtin_nontemporal_load(xr + 64 * j); s += (v[j].x * v[j].x + v[j].y * v[j].y) + (v[j].z * v[j].z + v[j].w * v[j].w); }
        s = wave_sum(s);
        const float rs = __builtin_amdgcn_rsqf(s * (1.0f / 1024.0f) + 1e-6f);
        GAS v2u* o8 = (GAS v2u*)(a.XB + (size_t)m * DM) + lane;
#pragma unroll
        for (int j = 0; j < 4; ++j) o8[64 * j] = (v2u){pkbf(v[j].x * rs, v[j].y * rs), pkbf(v[j].z * rs, v[j].w * rs)};
    }
}

__device__ __forceinline__ int crow(int r, int hi) { return (r & 3) + 8 * (r >> 2) + 4 * hi; }
__device__ __forceinline__ unsigned f2ord(float f) { const unsigned b = __float_as_uint(f); return (b & 0x80000000u) ? ~b : (b | 0x80000000u); }
#define MFMA32(a, b, c) __builtin_amdgcn_mfma_f32_32x32x16_bf16(a, b, c, 0, 0, 0)

__device__ __forceinline__ void cumsum_unit(LAS unsigned char* lds, const float* src, LAS float* dst, int tid, int wave, int lane) {
    asm volatile("" : "+v"(tid), "+v"(lane));
    LAS float* wsum = (LAS float*)lds;
    f32x4 v = *(const f32x4*)(src + 4 * tid);
    v.y += v.x; v.z += v.y; v.w += v.z;
    float t = v.w;
#pragma unroll
    for (int o = 1; o < 64; o <<= 1) { const float n = __shfl_up(t, o); if (lane >= o) t += n; }
    if (lane == 63) wsum[wave] = t;
    __syncthreads();
    float base = t - v.w;
    for (int w = 0; w < wave; ++w) base += wsum[w];
    *(LAS f32x4*)(dst + 4 * tid) = (f32x4){v.x + base, v.y + base, v.z + base, v.w + base};
    LDS_WAIT(); __syncthreads();
}

__device__ __forceinline__ void cnt4(unsigned& c0, unsigned& c1, unsigned& c2, unsigned& c3, unsigned a, unsigned b, unsigned c, unsigned d, unsigned C) {
    unsigned long long m0, m1, m2, m3;
    asm volatile("v_cmp_ge_u32_e64 %4, %8, %12\n\tv_cmp_ge_u32_e64 %5, %9, %12\n\tv_cmp_ge_u32_e64 %6, %10, %12\n\tv_cmp_ge_u32_e64 %7, %11, %12\n\t"
                 "v_addc_co_u32_e64 %0, vcc, 0, %0, %4\n\tv_addc_co_u32_e64 %1, vcc, 0, %1, %5\n\tv_addc_co_u32_e64 %2, vcc, 0, %2, %6\n\tv_addc_co_u32_e64 %3, vcc, 0, %3, %7"
                 : "+v"(c0), "+v"(c1), "+v"(c2), "+v"(c3), "=&s"(m0), "=&s"(m1), "=&s"(m2), "=&s"(m3) : "v"(a), "v"(b), "v"(c), "v"(d), "v"(C) : "vcc");
}
constexpr int IX_QI = 0, IX_HIST = 0  , IX_RED = 36864 - 4096, IX_GT = 36864, IX_EQ = IX_GT + 32 * 65 * 4, IX_NEED = IX_EQ + 32 * 65 * 4, IX_WQ = IX_NEED + 256, IX_RES = IX_WQ + 1024, IX_END = IX_RES + 512, IX_U = 57344  ;
static_assert(IX_END <= IX_U && IX_U + 65536 <= 122880, "indexer LDS map (the attention tables sit above it)");
static_assert(32 * 257 * 4 <= IX_RED + 4096, "histograms fit below the mask words");
__device__ __forceinline__ void idx_unit(LAS unsigned char* lds, int b, int qt, const bf16* IQ, const bf16* IK, const float* IWS, unsigned* SEL, int tid, int w, int lane) {
    asm volatile("" : "+v"(tid), "+v"(lane));
    const int r32 = lane & 31, hi = lane >> 5;
    const int q0 = qt * 32, nkt = qt + 1; const size_t rowq = (size_t)b * SEQ + q0;
    LAS unsigned* red = (LAS unsigned*)(lds + IX_RED); LAS unsigned* GT = (LAS unsigned*)(lds + IX_GT); LAS unsigned* EQm = (LAS unsigned*)(lds + IX_EQ); LAS unsigned* NEED = (LAS unsigned*)(lds + IX_NEED);
    const float wv_ = (tid < 256) ? IWS[rowq * 8 + tid] : 0.f;
    const char* kbase = (const char*)(IK + (size_t)b * SEQ * 64);
    unsigned koff = (unsigned)((w * 32 + r32) * 128 + hi * 16);
    bf16x8 kf0[4];
    if (w < nkt) {
#pragma unroll
        for (int ks = 0; ks < 4; ++ks) kf0[ks] = *(const bf16x8*)(kbase + koff + ks * 32); }
    { v4u qv[4];
#pragma unroll
      for (int i = 0; i < 4; ++i) { const int idx = tid + 512 * i, c = 2 * (idx >> 6) + ((idx >> 5) & 1), r = idx & 31; qv[i] = *(const GAS v4u*)(IQ + (rowq + r) * 512 + c * 8); }
      __builtin_amdgcn_sched_barrier(0);
#pragma unroll
      for (int i = 0; i < 4; ++i) { const int idx = tid + 512 * i, c = 2 * (idx >> 6) + ((idx >> 5) & 1), r = idx & 31; *(LAS v4u*)(lds + IX_QI + c * 512 + r * 16) = qv[i]; } }
    LAS float* wql = (LAS float*)(lds + IX_WQ);
    if (tid < 256) wql[(tid & 7) * 32 + (tid >> 3)] = wv_;
    if (tid < 32) { LAS unsigned* RESi = (LAS unsigned*)(lds + IX_RES); RESi[tid * 4 + 0] = 0u; RESi[tid * 4 + 1] = (unsigned)TOPK; RESi[tid * 4 + 2] = 0u; }
    LDS_WAIT(); __syncthreads();
    unsigned u[6][16];
    LAS unsigned char* uw = lds + IX_U + w * 8192 + lane * 16;
    const LAS unsigned char* qb = lds + IX_QI + hi * 512 + r32 * 16;
    {
    bf16x8 kf[2][4];
#pragma unroll
    for (int ks = 0; ks < 4; ++ks) kf[0][ks] = kf0[ks];
    bf16x8 qa[4], qc[4]; float wa, wc;
#define IDX_QREAD(dst, wdst, h_) do { _Pragma("unroll") for (int ks = 0; ks < 4; ++ks) dst[ks] = *(const LAS bf16x8*)(qb + ((h_) * 4 + ks) * 1024); wdst = wql[(h_) * 32 + r32]; } while (0)
#define IDX_HEAD(src, wsrc) do { f32x16 acc = f32x16{}; _Pragma("unroll") for (int ks = 0; ks < 4; ++ks) acc = MFMA32(kf[j & 1][ks], src[ks], acc); \
        _Pragma("unroll") for (int r = 0; r < 16; ++r) { int xi = __float_as_int(acc[r]); xi = xi > 0 ? xi : 0; sc[r] = __builtin_fmaf(wsrc, __int_as_float(xi), sc[r]); } } while (0)
    IDX_QREAD(qa, wa, 0);
#pragma unroll
    for (int j = 0; j < 8; ++j) {
        const int kt = w + 8 * j;
        if (kt < nkt) {
            f32x16 sc = f32x16{};
#pragma unroll 1
            for (int h = 0; h < 8; h += 2) {
                IDX_QREAD(qc, wc, h + 1); __builtin_amdgcn_sched_barrier(0);
                IDX_HEAD(qa, wa); __builtin_amdgcn_sched_barrier(0);
                if (h == 0 && j < 7 && kt + 8 < nkt) { asm volatile("" : "+v"(koff)); const char* kp = kbase + koff + (j + 1) * 32768;
#pragma unroll
                    for (int ks = 0; ks < 4; ++ks) kf[(j + 1) & 1][ks] = *(const bf16x8*)(kp + ks * 32); }
                __builtin_amdgcn_sched_barrier(0);
                IDX_QREAD(qa, wa, (h + 2) & 7); __builtin_amdgcn_sched_barrier(0);
                IDX_HEAD(qc, wc); __builtin_amdgcn_sched_barrier(0);
            }
            const bool diag = (kt == qt);
            unsigned o[16];
#pragma unroll
            for (int r = 0; r < 16; ++r) { o[r] = f2ord(sc[r]); if (diag && crow(r, hi) > r32) o[r] = 0u; }
            if (j < 6) {
#pragma unroll
                for (int r = 0; r < 16; ++r) u[j < 6 ? j : 0][r] = o[r];
            } else {
#pragma unroll
                for (int r4 = 0; r4 < 4; ++r4) *(LAS v4u*)(uw + (j - 6) * 4096 + r4 * 1024) = (v4u){o[4 * r4], o[4 * r4 + 1], o[4 * r4 + 2], o[4 * r4 + 3]};
            }
        } else if (j < 6) {
#pragma unroll
            for (int r = 0; r < 16; ++r) u[j < 6 ? j : 0][r] = 0u;
        }
    }
#undef IDX_QREAD
#undef IDX_HEAD
    }
#define IDX_UKEYS(j_, uk) unsigned uk[16]; if ((j_) < 6) { _Pragma("unroll") for (int r = 0; r < 16; ++r) uk[r] = u[(j_) < 6 ? (j_) : 0][r]; } else { _Pragma("unroll") for (int r4 = 0; r4 < 4; ++r4) { const v4u t_ = *(const LAS v4u*)(uw + ((j_) - 6) * 4096 + r4 * 1024); uk[4 * r4] = t_.x; uk[4 * r4 + 1] = t_.y; uk[4 * r4 + 2] = t_.z; uk[4 * r4 + 3] = t_.w; } }
    const unsigned nvalid = (unsigned)(q0 + r32 + 1);
    LAS unsigned* HIST = (LAS unsigned*)(lds + IX_HIST); LAS unsigned* RES = (LAS unsigned*)(lds + IX_RES);
    unsigned tp = 0u, rank = (unsigned)TOPK, cnteq = 0u;
    const bool anysel = __any(nvalid > (unsigned)TOPK);
    if (anysel) {
        __syncthreads();
#pragma unroll 1
        for (int ps = 0; ps < 4; ++ps) {
            const int sft = 24 - 8 * ps;
            for (int i = tid; i < 32 * 257; i += NTHREADS) HIST[i] = 0u;
            LDS_WAIT(); __syncthreads();
            { const unsigned pf = tp >> sft; LAS unsigned* hq = HIST + r32 * 257;
#pragma unroll
              for (int j = 0; j < 8; ++j) if (w + 8 * j < nkt) { IDX_UKEYS(j, uk)
#pragma unroll
                  for (int r = 0; r < 16; ++r) { unsigned d = (uk[r] >> sft) - pf; d = d < 256u ? d : 256u; (void)__hip_atomic_fetch_add(hq + d, 1u, __ATOMIC_RELAXED, __HIP_MEMORY_SCOPE_WORKGROUP); } } }
            LDS_WAIT(); __syncthreads();
            {
              const int g = lane >> 4, i16 = lane & 15, q = 4 * w + g; const LAS unsigned* hq = HIST + q * 257 + (240 - 16 * i16);
              unsigned hv[16], sl = 0u;
#pragma unroll
              for (int k = 0; k < 16; ++k) { hv[k] = hq[k]; sl += hv[k]; }
              unsigned inc = sl;
#pragma unroll
              for (int o = 1; o < 16; o <<= 1) { const unsigned n = (unsigned)__shfl_up((int)inc, o, 16); if (i16 >= o) inc += n; }
              const unsigned exc = inc - sl;
              const unsigned rk = RES[q * 4 + 1];
              if (exc < rk && rk <= inc) { unsigned above = exc, bsel = 0u, bcnt = 0u; bool found = false;
#pragma unroll
                  for (int k = 15; k >= 0; --k) { if (!found) { if (rk <= above + hv[k]) { found = true; bsel = (unsigned)(240 - 16 * i16 + k); bcnt = hv[k]; } else above += hv[k]; } }
                  RES[q * 4 + 0] = RES[q * 4 + 0] | (bsel << sft); RES[q * 4 + 1] = rk - above; RES[q * 4 + 2] = bcnt; } }
            LDS_WAIT(); __syncthreads();
            tp = RES[r32 * 4 + 0]; rank = RES[r32 * 4 + 1]; cnteq = RES[r32 * 4 + 2];
            if (__all(nvalid <= (unsigned)TOPK || rank == cnteq)) break;
        }
    }
    bool tie = (nvalid > (unsigned)TOPK) && (rank != cnteq); bool done = !tie;
    const unsigned P = (nvalid > (unsigned)TOPK) ? tp : 1u;
    const unsigned need = tie ? rank : 0u;
    const bool anynd = __any(tie);
    const bool useeq = tie;
#pragma unroll
    for (int j = 0; j < 8; ++j) { const int kt = w + 8 * j;
        if (kt < nkt) { unsigned gtw = 0u, eqw = 0u; IDX_UKEYS(j, uk)
#pragma unroll
            for (int r = 0; r < 16; ++r) { const int cb = (r & 3) + 8 * (r >> 2); const unsigned v = uk[r];
                const bool sg = done ? (v >= P) : (v > P); const bool se = useeq && (v == P);
                gtw |= (sg ? 1u : 0u) << cb; eqw |= (se ? 1u : 0u) << cb; }
            gtw <<= 4 * hi; eqw <<= 4 * hi;
            gtw |= __shfl_xor(gtw, 32); eqw |= __shfl_xor(eqw, 32);
            if (lane < 32) { GT[r32 * 65 + kt] = gtw; EQm[r32 * 65 + kt] = eqw; } } }
    if (w == 0 && lane < 32) NEED[lane] = need;
    LDS_WAIT(); __syncthreads();
    if (anynd) {
        if (tid < 32) { unsigned rem = NEED[tid];
            for (int kt = 0; kt < nkt; ++kt) { unsigned e = EQm[tid * 65 + kt]; const unsigned c = (unsigned)__popc(e);
                if (c > rem) { while ((unsigned)__popc(e) > rem) e &= ~(0x80000000u >> __clz(e)); EQm[tid * 65 + kt] = e; }
                rem -= (unsigned)__popc(e); } }
        LDS_WAIT(); __syncthreads();
    }
}

constexpr int AT_KSLOT = 8448, AT_KCH = 1040;
constexpr int AT_K = 0, AT_V = 2 * AT_KSLOT, AT_M = AT_V + 16384, AT_CUM = AT_M + 8192, AT_WS = AT_CUM + 8192, AT_OST = AT_WS + 2048, AT_FLG = AT_OST + NWAVES * 4096, AT_SEL = AT_FLG + 64, AT_END = AT_SEL + 32 * 65 * 4;
constexpr int AT_LUT = 122880, LUTW = 240, AT_QKB = AT_LUT + 8 * LUTW * 4;
static_assert(AT_END <= AT_LUT && AT_QKB + 64 <= 131072, "attention LDS map");
constexpr float ATT_THR = 20.0f;
__device__ __forceinline__ int t5_bucket(int rel) {
    if (rel < 16) return rel;
    int b = 15;
    constexpr int th[16] = {16, 19, 21, 24, 27, 31, 35, 40, 46, 52, 59, 67, 77, 87, 99, 113};
#pragma unroll
    for (int i = 0; i < 16; ++i) b += (rel >= th[i]) ? 1 : 0;
    return b;
}
typedef short v4i16_t __attribute__((ext_vector_type(4)));
__device__ __forceinline__ s16x4 vtr(const LAS unsigned char* p) { return __builtin_bit_cast(s16x4, __builtin_amdgcn_ds_read_tr16_b64_v4i16((LAS v4i16_t*)p)); }
__device__ __forceinline__ float max3f(float a, float b, float c) { float r; asm("v_max3_f32 %0, %1, %2, %3" : "=v"(r) : "v"(a), "v"(b), "v"(c)); return r; }
__device__ __forceinline__ float rowmax32(const f32x16& p0, const f32x16& p1) {
    float a = max3f(p0[0], p0[1], p1[0]), c = max3f(p0[2], p0[3], p1[1]); a = max3f(a, p1[2], p1[3]);
#pragma unroll
    for (int r = 4; r < 16; r += 4) { a = max3f(a, p0[r], p0[r + 1]); c = max3f(c, p0[r + 2], p0[r + 3]); a = max3f(a, p1[r], p1[r + 1]); c = max3f(c, p1[r + 2], p1[r + 3]); }
    a = __builtin_fmaxf(a, c);
    return __builtin_fmaxf(a, __shfl_xor(a, 32));
}
template <bool SREF>
__device__ __forceinline__ void softmax_pv(f32x16& p0, f32x16& p1, float& mref, f32x16& lacc, f32x16 (&o)[2], LAS float* wsf, const LAS unsigned char* vslot, int lane, int r32, int hi) {
    if (!SREF) {
    asm volatile("s_nop 13" : "+v"(p0), "+v"(p1));
    const float rm = rowmax32(p0, p1);
    if (__any(rm > ATT_THR)) {
        const float dl = rm > 0.f ? rm : 0.f, f = __builtin_amdgcn_exp2f(-dl);
        mref += dl;
        if (hi == 0) wsf[r32] = f;
#pragma unroll
        for (int r = 0; r < 16; ++r) { p0[r] -= dl; p1[r] -= dl; }
        LDS_WAIT();
        const LAS float* wsf4 = wsf + 4 * hi;
#pragma unroll
        for (int r = 0; r < 16; ++r) { const float a = wsf4[(r & 3) + 8 * (r >> 2)]; o[0][r] *= a; o[1][r] *= a; lacc[r] *= a; }
    }
    }
    const LAS unsigned char* vp = vslot + ((lane >> 4) & 1) * 32 + (lane & 3) * 8 + (4 * hi + ((lane & 15) >> 2)) * 64;
    s16x4 vlo[8], vhh[8];
#pragma unroll
    for (int i = 0; i < 8; ++i) { vlo[i] = vtr(vp + (i >> 2) * 4096 + (i & 3) * 1024); vhh[i] = vtr(vp + (i >> 2) * 4096 + (i & 3) * 1024 + 512); }
    __builtin_amdgcn_sched_barrier(0);
#pragma unroll
    for (int r = 0; r < 16; ++r) { p0[r] = __builtin_amdgcn_exp2f(p0[r]); p1[r] = __builtin_amdgcn_exp2f(p1[r]); }
    v4u pw[4];
    pw[0] = (v4u){pkbf(p0[0], p0[1]), pkbf(p0[2], p0[3]), pkbf(p0[4], p0[5]), pkbf(p0[6], p0[7])};
    pw[1] = (v4u){pkbf(p0[8], p0[9]), pkbf(p0[10], p0[11]), pkbf(p0[12], p0[13]), pkbf(p0[14], p0[15])};
    pw[2] = (v4u){pkbf(p1[0], p1[1]), pkbf(p1[2], p1[3]), pkbf(p1[4], p1[5]), pkbf(p1[6], p1[7])};
    pw[3] = (v4u){pkbf(p1[8], p1[9]), pkbf(p1[10], p1[11]), pkbf(p1[12], p1[13]), pkbf(p1[14], p1[15])};
    __builtin_amdgcn_sched_barrier(0);
#pragma unroll
    for (int i = 0; i < 8; ++i) { const bf16x8 vf = (bf16x8){vlo[i][0], vlo[i][1], vlo[i][2], vlo[i][3], vhh[i][0], vhh[i][1], vhh[i][2], vhh[i][3]};
        o[i >> 2] = MFMA32(__builtin_bit_cast(bf16x8, pw[i & 3]), vf, o[i >> 2]); }
    const bf16x8 ones = (bf16x8){(short)0x3f80, (short)0x3f80, (short)0x3f80, (short)0x3f80, (short)0x3f80, (short)0x3f80, (short)0x3f80, (short)0x3f80};
#pragma unroll
    for (int i = 0; i < 4; ++i) lacc = MFMA32(__builtin_bit_cast(bf16x8, pw[i]), ones, lacc);
}
__device__ __forceinline__ void attn_store(const f32x16& lacc, const f32x16 (&o)[2], LAS float* wsf, LAS bf16* stg, bf16* Ow, int lane, int r32, int hi) {
    LAS bf16* stg4 = stg + (4 * hi) * 64 + r32;
#pragma unroll
    for (int r = 0; r < 16; ++r) { const int oc = (r & 3) + 8 * (r >> 2); const float rl = __builtin_amdgcn_rcpf(lacc[r]);
        const unsigned a = pkbf(o[0][r] * rl, 0.f), c = pkbf(o[1][r] * rl, 0.f);
        stg4[oc * 64] = (bf16)(a & 0xffffu); stg4[oc * 64 + 32] = (bf16)(c & 0xffffu); }
    LDS_WAIT();
#pragma unroll
    for (int i = 0; i < 4; ++i) { const int row = i * 8 + (lane >> 3), ch = lane & 7; const v4u v = *(const LAS v4u*)(stg + row * 64 + ch * 8); *(GAS v4u*)(Ow + (size_t)row * 512 + ch * 8) = v; }
}

template <bool SREF>
__device__ __forceinline__ void fox_unit(LAS unsigned char* lds, int b, int h, int qblk, const bf16* Q, const bf16* K, const bf16* V, bf16* O, const float* CUM2, int tid, int w, int lane) {
    asm volatile("" : "+v"(tid), "+v"(lane));
    constexpr int KP = 512;
    const int r32 = lane & 31, hi = lane >> 5;
    const int q0u = 256 * qblk, q0w = q0u + 32 * w, NT = 4 * (qblk + 1);
    const size_t rowb = (size_t)b * SEQ;
    const bf16* Kb = K + rowb * KP + h * 64; const bf16* Vb = V + rowb * KP + h * 64;
    LAS float* wsf = (LAS float*)(lds + AT_WS) + w * 64;
    LAS float* cums = (LAS float*)(lds + AT_CUM);
    const int kc = tid & 7, krow = tid >> 3; const bf16* ksrc = Kb + (size_t)krow * KP + kc * 8; const int kdst = AT_K + kc * AT_KCH + krow * 16;
    const int vrow = tid >> 3, vdh = (tid >> 2) & 1, vq4 = tid & 3; const bf16* vsrc = Vb + (size_t)vrow * KP + vdh * 32 + vq4 * 8; const int vdst = AT_V + vdh * 4096 + vrow * 64 + vq4 * 16;
    v4u kreg = *(const GAS v4u*)(ksrc + (size_t)(NT - 1) * 64 * KP), vreg = *(const GAS v4u*)(vsrc + (size_t)(NT - 1) * 64 * KP);
    v4u kreg2 = (v4u){0u, 0u, 0u, 0u}, vreg2 = kreg2;
    if (NT > 1) { kreg2 = *(const GAS v4u*)(ksrc + (size_t)(NT - 2) * 64 * KP); vreg2 = *(const GAS v4u*)(vsrc + (size_t)(NT - 2) * 64 * KP); }
    LAS unsigned* flg = (LAS unsigned*)(lds + AT_FLG);
    if (tid < 16) flg[tid] = 0u;
    const float qkb = *(const LAS float*)(lds + AT_QKB);
    bf16x8 qr[4];
    { const bf16* Qw = Q + (rowb + q0w + r32) * 512 + h * 64 + hi * 8;
#pragma unroll
      for (int d0 = 0; d0 < 4; ++d0) qr[d0] = *(const bf16x8*)(Qw + d0 * 16); }
    const float cq = cums[q0w + r32];
    *(LAS v4u*)(lds + kdst) = kreg; *(LAS v4u*)(lds + vdst) = vreg;
    float mref = -qkb; f32x16 l = f32x16{}; f32x16 o[2]; o[0] = f32x16{}; o[1] = f32x16{};
    bool wdone = false;
    LDS_WAIT(); __syncthreads();
    asm volatile("" : "+v"(qr[0]), "+v"(qr[1]), "+v"(qr[2]), "+v"(qr[3]));
    auto step = [&](const int it, v4u& kL, v4u& vL, const v4u& kW, const v4u& vW) __attribute__((always_inline)) -> bool {
        const int t = NT - 1 - it; const int slot = (it & 1) * 8192;
        if (t > 1) { kL = *(const GAS v4u*)(ksrc + (size_t)(t - 2) * 64 * KP); vL = *(const GAS v4u*)(vsrc + (size_t)(t - 2) * 64 * KP); }
        if ((64 * t <= q0w + 31) && !wdone) {
            f32x16 p0, p1; const float e0 = cq - mref;
            { const LAS float* ck = cums + 64 * t + 4 * hi;
#pragma unroll
              for (int g = 0; g < 4; ++g) { const f32x4 c0 = *(const LAS f32x4*)(ck + 8 * g), c1 = *(const LAS f32x4*)(ck + 32 + 8 * g);
#pragma unroll
                  for (int e = 0; e < 4; ++e) { p0[4 * g + e] = e0 - c0[e]; p1[4 * g + e] = e0 - c1[e]; } } }
            const LAS unsigned char* kb = lds + AT_K + (it & 1) * AT_KSLOT + hi * AT_KCH + r32 * 16;
            bf16x8 kfr[8];
#pragma unroll
            for (int d0 = 0; d0 < 4; ++d0) { kfr[2 * d0] = *(const LAS bf16x8*)(kb + d0 * (2 * AT_KCH)); kfr[2 * d0 + 1] = *(const LAS bf16x8*)(kb + d0 * (2 * AT_KCH) + 512); }
            __builtin_amdgcn_sched_barrier(0);
#pragma unroll
            for (int d0 = 0; d0 < 4; ++d0) { p0 = MFMA32(kfr[2 * d0], qr[d0], p0); p1 = MFMA32(kfr[2 * d0 + 1], qr[d0], p1); }
            if (64 * t + 63 > q0w) { const int qa = q0w + r32, kb0 = 64 * t + 4 * hi;
#pragma unroll
                for (int r = 0; r < 16; ++r) { const int kv = kb0 + (r & 3) + 8 * (r >> 2); if (kv > qa) p0[r] = NEGBIG; if (kv + 32 > qa) p1[r] = NEGBIG; } }
            softmax_pv<SREF>(p0, p1, mref, l, o, wsf, lds + AT_V + slot, lane, r32, hi);
        }
        if (t > 0) { const int ns = ((it + 1) & 1) * 8192, nk = ((it + 1) & 1) * AT_KSLOT; *(LAS v4u*)(lds + kdst + nk) = kW; *(LAS v4u*)(lds + vdst + ns) = vW; }
        if (!wdone && t > 0 && (64 * t <= q0w + 31)) { const float cend = cums[64 * t - 1]; wdone = __all((qkb + cq - cend - mref) < -150.0f); }
        if (lane == 0) flg[(it & 1) * 8 + w] = wdone ? 1u : 0u;
        LDS_WAIT(); __syncthreads();
        const LAS v4u* fp = (const LAS v4u*)(flg + (it & 1) * 8); const v4u f0 = fp[0], f1 = fp[1];
        return (f0.x & f0.y & f0.z & f0.w & f1.x & f1.y & f1.z & f1.w) != 0u;
    };
    for (int it = 0; it < NT; it += 2) {
        if (step(it, kreg, vreg, kreg2, vreg2)) break;
        if (it + 1 < NT) { if (step(it + 1, kreg2, vreg2, kreg, vreg)) break; }
    }
    attn_store(l, o, wsf, (LAS bf16*)(lds + AT_OST) + w * 2048, O + (rowb + q0w) * 512 + h * 64, lane, r32, hi);
    LDS_WAIT(); __syncthreads();
}

template <bool SREF>
__device__ __forceinline__ void dsa_unit(LAS unsigned char* lds, int b, int qt, const bf16* Q, const bf16* K, const bf16* V, bf16* O, const unsigned* SEL, int tid, int w, int lane) {
    asm volatile("" : "+v"(tid), "+v"(lane));
    constexpr int KP = 64;
    const int r32 = lane & 31, hi = lane >> 5;
    const int q0w = 32 * qt, NT = (qt + 2) >> 1;
    const size_t rowb = (size_t)b * SEQ;
    const bf16* Kb = K + rowb * KP; const bf16* Vb = V + rowb * KP;
    LAS float* wsf = (LAS float*)(lds + AT_WS) + w * 64;
    const LAS float* lut = (const LAS float*)(lds + AT_LUT) + w * LUTW + 64;
    const int kc = tid & 7, krow = tid >> 3; const bf16* ksrc = Kb + (size_t)krow * KP + kc * 8; const int kdst = AT_K + kc * AT_KCH + krow * 16;
    const int vrow = tid >> 3, vdh = (tid >> 2) & 1, vq4 = tid & 3; const bf16* vsrc = Vb + (size_t)vrow * KP + vdh * 32 + vq4 * 8; const int vdst = AT_V + vdh * 4096 + vrow * 64 + vq4 * 16;
    const int mf = tid >> 1, mpart = tid & 1, mhh = mf >> 7, mks = (mf >> 6) & 1, mL = mf & 63, mq = mL & 31, mhi = mL >> 5;
    const int msh = 8 * (2 * mks + mpart) + 4 * mhi; const int mdst = AT_M + ((mhh * 2 + mks) * 64 + mL) * 16 + mpart * 8;
    LAS unsigned* selc = (LAS unsigned*)(lds + AT_SEL);
    { const int sr = tid >> 4, sc = (tid & 15) * 4; const LAS unsigned* gtw = (const LAS unsigned*)(lds + IX_GT) + sr * 65 + sc; const LAS unsigned* eqw = (const LAS unsigned*)(lds + IX_EQ) + sr * 65 + sc;
      LAS unsigned* d = selc + sr * 65 + sc;
#pragma unroll
      for (int k = 0; k < 4; ++k) d[k] = (sc + k <= qt) ? (gtw[k] | eqw[k]) : 0u; }
    const LAS unsigned* mword = selc + mq * 65 + mhh;
    v4u kreg = *(const GAS v4u*)(ksrc + (size_t)(NT - 1) * 64 * KP), vreg = *(const GAS v4u*)(vsrc + (size_t)(NT - 1) * 64 * KP);
    v4u kreg2 = (v4u){0u, 0u, 0u, 0u}, vreg2 = kreg2;
    if (NT > 1) { kreg2 = *(const GAS v4u*)(ksrc + (size_t)(NT - 2) * 64 * KP); vreg2 = *(const GAS v4u*)(vsrc + (size_t)(NT - 2) * 64 * KP); }
    const float sb = *(const LAS float*)(lds + AT_QKB + 4);
    bf16x8 qr[4];
    { const bf16* Qw = Q + (rowb + q0w + r32) * 512 + w * 64 + hi * 8;
#pragma unroll
      for (int d0 = 0; d0 < 4; ++d0) qr[d0] = *(const bf16x8*)(Qw + d0 * 16); }
    bf16x8 idn[2];
    { const int e = r32 - 4 * hi; const bool val = (e >= 0) && ((e & 4) == 0); const int kss = e >> 4, js = (e & 3) + 4 * ((e >> 3) & 1);
      const unsigned one = val ? (0x3f80u << (16 * (js & 1))) : 0u; const int dw = js >> 1;
#pragma unroll
      for (int ks = 0; ks < 2; ++ks) { v4u f; f.x = (kss == ks && dw == 0) ? one : 0u; f.y = (kss == ks && dw == 1) ? one : 0u; f.z = (kss == ks && dw == 2) ? one : 0u; f.w = (kss == ks && dw == 3) ? one : 0u;
          idn[ks] = __builtin_bit_cast(bf16x8, f); } }
#define DSA_MWRITE(t_, slotoff) do { const unsigned nib_ = (mword[2 * (t_)] >> msh) & 0xfu; v2u mv_; \
        mv_.x = ((nib_ & 1u) ? 0u : 0xf14au) | ((nib_ & 2u) ? 0u : 0xf14a0000u); mv_.y = ((nib_ & 4u) ? 0u : 0xf14au) | ((nib_ & 8u) ? 0u : 0xf14a0000u); \
        *(LAS v2u*)(lds + mdst + (slotoff)) = mv_; } while (0)
    *(LAS v4u*)(lds + kdst) = kreg; *(LAS v4u*)(lds + vdst) = vreg;
    LDS_WAIT(); __syncthreads();
    DSA_MWRITE(NT - 1, 0);
    float mref = SREF ? 0.f : -sb; f32x16 l = f32x16{}; f32x16 o[2]; o[0] = f32x16{}; o[1] = f32x16{};
    f32x16 negm;
#pragma unroll
    for (int r = 0; r < 16; ++r) negm[r] = SREF ? 0.f : sb;
    LDS_WAIT(); __syncthreads();
    asm volatile("" : "+v"(qr[0]), "+v"(qr[1]), "+v"(qr[2]), "+v"(qr[3]));
    auto step = [&](const int it, v4u& kL, v4u& vL, const v4u& kW, const v4u& vW) __attribute__((always_inline)) {
        const int t = NT - 1 - it; const int slot = (it & 1) * 8192, mslot = (it & 1) * 4096;
        if (t > 1) { kL = *(const GAS v4u*)(ksrc + (size_t)(t - 2) * 64 * KP); vL = *(const GAS v4u*)(vsrc + (size_t)(t - 2) * 64 * KP); }
        {
            f32x16 p0, p1;
            const LAS unsigned char* kb = lds + AT_K + (it & 1) * AT_KSLOT + hi * AT_KCH + r32 * 16; const LAS unsigned char* mb = lds + AT_M + mslot + lane * 16;
            bf16x8 kfr[8], mfr[4];
#pragma unroll
            for (int d0 = 0; d0 < 4; ++d0) { kfr[2 * d0] = *(const LAS bf16x8*)(kb + d0 * (2 * AT_KCH)); kfr[2 * d0 + 1] = *(const LAS bf16x8*)(kb + d0 * (2 * AT_KCH) + 512); }
#pragma unroll
            for (int ks = 0; ks < 2; ++ks) { mfr[2 * ks] = *(const LAS bf16x8*)(mb + ks * 1024); mfr[2 * ks + 1] = *(const LAS bf16x8*)(mb + 2048 + ks * 1024); }
            __builtin_amdgcn_sched_barrier(0);
            p0 = MFMA32(kfr[0], qr[0], negm); p1 = MFMA32(kfr[1], qr[0], negm);
#pragma unroll
            for (int d0 = 1; d0 < 4; ++d0) { p0 = MFMA32(kfr[2 * d0], qr[d0], p0); p1 = MFMA32(kfr[2 * d0 + 1], qr[d0], p1); }
#pragma unroll
            for (int ks = 0; ks < 2; ++ks) { p0 = MFMA32(idn[ks], mfr[2 * ks], p0); p1 = MFMA32(idn[ks], mfr[2 * ks + 1], p1); }
            if (64 * t + 63 + 113 > q0w) {
                int rel0 = q0w + r32 - 64 * t - 4 * hi; rel0 = rel0 > 172 ? 172 : rel0;
                const LAS float* lb = lut + rel0;
#pragma unroll
                for (int r = 0; r < 16; ++r) { const int cr = (r & 3) + 8 * (r >> 2); p0[r] += lb[-cr]; p1[r] += lb[-cr - 32]; } }
            const float mold = mref;
            softmax_pv<SREF>(p0, p1, mref, l, o, wsf, lds + AT_V + slot, lane, r32, hi);
            if constexpr (!SREF) { if (mref != mold) {
#pragma unroll
                for (int r = 0; r < 16; ++r) negm[r] = -mref; } }
        }
        if (t > 0) { const int ns = ((it + 1) & 1) * 8192, nk = ((it + 1) & 1) * AT_KSLOT; *(LAS v4u*)(lds + kdst + nk) = kW; *(LAS v4u*)(lds + vdst + ns) = vW; DSA_MWRITE(t - 1, ((it + 1) & 1) * 4096); }
        LDS_WAIT(); __syncthreads();
    };
    for (int it = 0; it < NT; it += 2) {
        step(it, kreg, vreg, kreg2, vreg2);
        if (it + 1 < NT) step(it + 1, kreg2, vreg2, kreg, vreg);
    }
#undef DSA_MWRITE
    attn_store(l, o, wsf, (LAS bf16*)(lds + AT_OST) + w * 2048, O + (rowb + q0w) * 512 + w * 64, lane, r32, hi);
    LDS_WAIT(); __syncthreads();
}

struct Args { const float* in[20]; float* out; unsigned char* ws; int ph_lo, ph_hi, li, pad; };
__global__ void __launch_bounds__(NTHREADS, 2) hyb_fwd(Args args) {
    extern __shared__ __attribute__((aligned(16))) unsigned char lds_raw[];
    LAS unsigned char* lds = (LAS unsigned char*)lds_raw;
    volatile LAS unsigned* MISC = (volatile LAS unsigned*)(lds + MISC_OFF);
    const int wave = __builtin_amdgcn_readfirstlane((int)threadIdx.x >> 6);
#define TID_LANE const int lane = fresh_lane(), tid = wave * 64 + lane; (void)tid; (void)lane
    const int G = gridDim.x; const int bx = blockIdx.x; const int vcu = (G % 8 == 0) ? (bx % 8) * (G / 8) + bx / 8 : bx;
    unsigned char* ws = args.ws;
    gu32* ctl = (gu32*)(ws + WS_CTL);
    const float* x = args.in[0]; const float* n1 = args.in[1]; const float* wg1 = args.in[2]; const float* wu1 = args.in[3]; const float* wd1 = args.in[4];
    const float* nm = args.in[5]; const float* win = args.in[6]; const float* bforget = args.in[7]; const float* gfq = args.in[8]; const float* gfk = args.in[9];
    const float* gdq = args.in[10]; const float* gdk = args.in[11]; const float* relb = args.in[12]; const float* wa = args.in[13]; const float* wb = args.in[14];
    const float* wout = args.in[15]; const float* n2 = args.in[16]; const float* wg2 = args.in[17]; const float* wu2 = args.in[18]; const float* wd2 = args.in[19];
    float* out = args.out;
    bf16* Wgu1 = (bf16*)(ws + WS_WGU1); bf16* Wd1 = (bf16*)(ws + WS_WD1); bf16* Win = (bf16*)(ws + WS_WIN); bf16* Wa = (bf16*)(ws + WS_WA); bf16* Wb = (bf16*)(ws + WS_WB);
    bf16* Wout = (bf16*)(ws + WS_WOUT); bf16* Wgu2 = (bf16*)(ws + WS_WGU2); bf16* Wd2 = (bf16*)(ws + WS_WD2);
    bf16* XB = (bf16*)(ws + WS_XB); float* SS = (float*)(ws + WS_SS); float* LOGF2 = (float*)(ws + WS_LOGF); float* CUM2 = (float*)(ws + WS_CUM); float* IWS = (float*)(ws + WS_IW);
    unsigned* SEL = (unsigned*)(ws + WS_SEL);
    bf16* FQ = (bf16*)(ws + WS_FQ); bf16* DQ = (bf16*)(ws + WS_DQ); bf16* FK = (bf16*)(ws + WS_FK); bf16* FV = (bf16*)(ws + WS_FV); bf16* IQ = (bf16*)(ws + WS_IQ);
    bf16* DK = (bf16*)(ws + WS_DK); bf16* DV = (bf16*)(ws + WS_DV); bf16* IK = (bf16*)(ws + WS_IK); bf16* GA = (bf16*)(ws + WS_GA); bf16* GB = (bf16*)(ws + WS_GB);
    bf16* HB = (bf16*)(ws + WS_H); bf16* MG = (bf16*)(ws + WS_MG);

    { TID_LANE; for (int u = tid; u < (LDS_BYTES - LDSCTL_OFF) / 4; u += NTHREADS) ((LAS unsigned*)(lds + LDSCTL_OFF))[u] = 0u; }
    __syncthreads();
    XcdBarrier bar; bar.bar = (unsigned*)(ctl + CW_BAR); bar.x = 0; bar.st = nullptr;
    if (N_LAUNCHES == 1) bar = xcd_barrier_post((unsigned*)(ctl + CW_BAR), MISC + 8, wave == 0 && fresh_lane() == 0);
    const int lo = args.ph_lo, hi = args.ph_hi;
#ifndef PROBE_DUP
#define PROBE_DUP 0
#endif
#define REP(k) for (int rep_ = 0; rep_ < (((PROBE_DUP >> (k)) & 1) ? 2 : 1); ++rep_)
#define IN(k) (lo <= (k) && (k) < hi)
#define SEAM(k) do { if (IN(k) && IN((k) + 1)) xcd_barrier(bar, wave == 0 && fresh_lane() == 0); } while (0)

    const P0Args p0a{x, n1, wg1, wu1, wd1, nm, win, wa, wb, wout, n2, wg2, wu2, wd2, Wgu1, Wd1, Win, Wa, Wb, Wout, Wgu2, Wd2, XB, SS};
    if (IN(0)) { TID_LANE;
        REP(0) p0_prologue(p0a, lds, vcu, G, wave, lane);
        SEAM(0);
    }
    if (IN(1)) { TID_LANE;
        pg8::Gemm g{XB, Wgu1, TOK, NGU, DM, XB, Wgu1}; pg8::StaticOrder S; S.init(TOK, NGU, G, bx);
        pg8::EpiGateUp<true> E{HB, SS, lds};
        REP(1) pg8::gemm_phase<pg8::EpiGateUp<true>, pg8::StaticOrder, true, true>(lds, g, S, E, wave, lane);
        SEAM(1);
    }
    if (IN(2)) { TID_LANE;
        pg8::Gemm g{HB, Wd1, TOK, DM, DFF, HB, Wd1}; pg8::StaticOrder S; S.init(TOK, DM, G, bx);
        pg8::EpiRes<false, true, false, 1> E{x, nullptr, XB, SS + (size_t)TOK * 16};
        pg8::gemm_phase<pg8::EpiRes<false, true, false, 1>, pg8::StaticOrder, true, true>(lds, g, S, E, wave, lane);
        SEAM(2);
    }
    if (IN(3)) { TID_LANE;
        pg8::Gemm g{XB, Win, TOK, NIN, DM, XB, Win}; pg8::StaticOrder S; S.init(TOK, NIN, G, bx);
        if (tid < 256) { const float* gsrc = (tid < 64) ? gfq : (tid < 128) ? gfk : (tid < 192) ? gdq : gdk; *(LAS float*)(lds + pg8::GAIN_LDS + 4 * tid) = gsrc[tid & 63]; }
        if (tid < 8) *(LAS float*)(lds + pg8::BF_LDS + 4 * tid) = bforget[tid];
        pg8::EpiWin E{SS + (size_t)TOK * 16, FQ, FK, FV, DQ, DK, DV, IQ, IK, GA, GB, LOGF2, IWS, bforget, lds};
        REP(3) pg8::gemm_phase<pg8::EpiWin, pg8::StaticOrder, true, true>(lds, g, S, E, wave, lane);
        SEAM(3);
    }
    if (IN(4)) { TID_LANE;
        { LAS float* lut = (LAS float*)(lds + AT_LUT);
          for (int i = tid; i < 8 * LUTW; i += NTHREADS) { const int hh = i / LUTW; int rel = i - hh * LUTW - 64; rel = rel < 0 ? 0 : (rel > 127 ? 127 : rel); lut[i] = (relb[t5_bucket(rel) * 8 + hh] - relb[31 * 8 + hh]) * LOG2E; }
          if (wave == 0) { float mq = __builtin_fabsf(gfq[lane]), mk = __builtin_fabsf(gfk[lane]), dq = __builtin_fabsf(gdq[lane]), dk = __builtin_fabsf(gdk[lane]);
              float mb = 0.f;
#pragma unroll
              for (int i = 0; i < 4; ++i) { const int idx = lane + 64 * i; mb = __builtin_fmaxf(mb, __builtin_fabsf(relb[idx] - relb[31 * 8 + (idx & 7)])); }
#pragma unroll
              for (int o = 1; o < 64; o <<= 1) { mq = __builtin_fmaxf(mq, __shfl_xor(mq, o)); mk = __builtin_fmaxf(mk, __shfl_xor(mk, o)); dq = __builtin_fmaxf(dq, __shfl_xor(dq, o)); dk = __builtin_fmaxf(dk, __shfl_xor(dk, o)); mb = __builtin_fmaxf(mb, __shfl_xor(mb, o)); }
              if (lane == 0) { *(LAS float*)(lds + AT_QKB) = 64.0f * C2 * mq * mk * 1.02f;
                               *(LAS float*)(lds + AT_QKB + 4) = 64.0f * C2 * dq * dk * 1.02f + mb * LOG2E; } }
          LDS_WAIT(); __syncthreads(); }
        const bool sref = (2.0f * *(const LAS float*)(lds + AT_QKB) < 96.0f) && (2.0f * *(const LAS float*)(lds + AT_QKB + 4) < 96.0f);
        for (int it = vcu; it < 256; it += G) {
            { const int pr = it >> 1, b = pr >> 3, h = pr & 7, odd = it & 1;
              cumsum_unit(lds, LOGF2 + (size_t)pr * SEQ, (LAS float*)(lds + AT_CUM), tid, wave, lane);
#pragma unroll 1
              for (int i = 0; i < 4; ++i) { const int qb = odd ? ((i == 0) ? 1 : (i == 1) ? 6 : (i == 2) ? 3 : 4) : ((i == 0) ? 0 : (i == 1) ? 7 : (i == 2) ? 2 : 5);
                  if (sref) fox_unit<true>(lds, b, h, qb, FQ, FK, FV, FQ, CUM2, tid, wave, lane); else fox_unit<false>(lds, b, h, qb, FQ, FK, FV, FQ, CUM2, tid, wave, lane); } }
            { const int b = it >> 4, s = it & 15;
              constexpr unsigned QT4[16] = {0x002a1d3cu, 0x071e213fu, 0x021c2c39u, 0x031b2d3au, 0x011a2e3bu, 0x05182f38u, 0x061f243du, 0x0419283eu,
                                            0x0e162036u, 0x09172637u, 0x0a142734u, 0x08152932u, 0x0c122235u, 0x0d132333u, 0x0b102b30u, 0x0f112531u};
              unsigned qts = 0u;
#pragma unroll
              for (int k = 0; k < 16; ++k) qts = (s == k) ? QT4[k] : qts;
#pragma unroll 1
              for (int i = 0; i < 4; ++i) { const int qt = (int)((qts >> (24 - 8 * i)) & 0xffu);
                  idx_unit(lds, b, qt, IQ, IK, IWS, SEL, tid, wave, lane);
                  if (sref) dsa_unit<true>(lds, b, qt, DQ, DK, DV, DQ, SEL, tid, wave, lane); else dsa_unit<false>(lds, b, qt, DQ, DK, DV, DQ, SEL, tid, wave, lane); } }
        }
        SEAM(4);
    }
    if (IN(6)) { TID_LANE;
        pg8::Gemm g{FQ, Wa, TOK, DM, HW, DQ, Wb}; pg8::PairOrder S; S.so.init(TOK, DM, G, bx);
        pg8::EpiBranch E{GA, GB, MG};
        REP(6) pg8::gemm_phase<pg8::EpiBranch, pg8::PairOrder, true, true>(lds, g, S, E, wave, lane);
        SEAM(6);
    }
    if (IN(7)) { TID_LANE;
        pg8::Gemm g{MG, Wout, TOK, DM, DM, MG, Wout}; pg8::StaticOrder S; S.init(TOK, DM, G, bx);
        pg8::EpiRes<true, true, false, 2> E{nullptr, nullptr, XB, SS + (size_t)2 * TOK * 16};
        pg8::gemm_phase<pg8::EpiRes<true, true, false, 2>, pg8::StaticOrder, true, true>(lds, g, S, E, wave, lane);
        SEAM(7);
    }
    if (IN(8)) { TID_LANE;
        pg8::Gemm g{XB, Wgu2, TOK, NGU, DM, XB, Wgu2}; pg8::StaticOrder S; S.init(TOK, NGU, G, bx);
        pg8::EpiGateUp<false> E{HB, SS + (size_t)2 * TOK * 16, lds};
        REP(8) pg8::gemm_phase<pg8::EpiGateUp<false>, pg8::StaticOrder, true, true>(lds, g, S, E, wave, lane);
        SEAM(8);
    }
    if (IN(9)) { TID_LANE;
        pg8::Gemm g{HB, Wd2, TOK, DM, DFF, HB, Wd2}; pg8::StaticOrder S; S.init(TOK, DM, G, bx);
        pg8::EpiRes<true, false, true, 1> E{nullptr, out, XB, nullptr};
        pg8::gemm_phase<pg8::EpiRes<true, false, true, 1>, pg8::StaticOrder, true, true>(lds, g, S, E, wave, lane);
    }
#undef IN
#undef REP
#undef SEAM
}

extern "C" void kernel_launch(void* const* d_in, const int* in_sizes, int n_in, void* d_out, int out_size, void* d_ws, size_t ws_size, hipStream_t stream) {
    static int grid = 0;
    if (grid == 0) {
        if (n_in != 20 || in_sizes[0] != TOK * DM || out_size != TOK * DM || ws_size < WS_END) { fprintf(stderr, "kernel_launch: unexpected shapes (n_in %d, in0 %d, out %d, ws %zu); nothing launched\n", n_in, n_in > 0 ? in_sizes[0] : -1, out_size, ws_size); grid = -1; return; }
        int dev = 0, cus = 0, per_cu = 0;
        if (hipGetDevice(&dev) != hipSuccess || hipDeviceGetAttribute(&cus, hipDeviceAttributeMultiprocessorCount, dev) != hipSuccess) { grid = -1; return; }
        if (hipFuncSetAttribute((const void*)hyb_fwd, hipFuncAttributeMaxDynamicSharedMemorySize, LDS_BYTES) != hipSuccess) { fprintf(stderr, "kernel_launch: hipFuncSetAttribute failed\n"); grid = -1; return; }
        if (hipOccupancyMaxActiveBlocksPerMultiprocessor(&per_cu, (const void*)hyb_fwd, NTHREADS, LDS_BYTES) != hipSuccess || per_cu < 1) { fprintf(stderr, "kernel_launch: occupancy query says %d blocks per CU\n", per_cu); per_cu = 1; }
        (void)hipGetLastError();
        grid = cus;
    }
    if (grid < 0) return;
    if (hipMemsetAsync((char*)d_ws + WS_CTL, 0, CTL_ZERO_BYTES, stream) != hipSuccess) return;
    Args a{};
    for (int i = 0; i < 20; ++i) a.in[i] = (const float*)d_in[i];
    a.out = (float*)d_out; a.ws = (unsigned char*)d_ws;
    if (N_LAUNCHES == 1) {
        a.ph_lo = 0; a.ph_hi = NPHASE; a.li = 0;
        hipLaunchKernelGGL(hyb_fwd, dim3(grid), dim3(NTHREADS), LDS_BYTES, stream, a);
    } else {
        for (int li = 0; li < NPHASE; ++li) { a.ph_lo = li; a.ph_hi = li + 1; a.li = li; hipLaunchKernelGGL(hyb_fwd, dim3(grid), dim3(NTHREADS), LDS_BYTES, stream, a); }
    }
    const hipError_t le = hipPeekAtLastError();
    if (le != hipSuccess) fprintf(stderr, "kernel_launch: launch failed: %s\n", hipGetErrorName(le));
}
```

```cpp
#include <hip/hip_runtime.h>
#include <hip/hip_bf16.h>
#include <cstdio>
#include <cstdint>

#ifndef MK_N_LAUNCHES
#define MK_N_LAUNCHES 1
#endif
#ifndef MK_STOP_AFTER
#define MK_STOP_AFTER 99
#endif

constexpr int BATCH = 16, SEQ = 2048, DM = 1024, TOK = BATCH * SEQ;
constexpr int DFF = 2816, NGU = 2 * DFF;
constexpr int NIN = 4864, IN_W = 4816;
constexpr int NHEAD = 8, HD = 64, HW = NHEAD * HD;
constexpr int TOPK = 256;
constexpr float EPS = 1e-6f;
constexpr float LOG2E = 1.4426950408889634f;
constexpr float C2 = 0.125f * LOG2E;
constexpr float NEGBIG = -1e30f;

namespace pg8 {
#define PG8_LAS __attribute__((address_space(3)))
typedef unsigned short bf16_t;
typedef short bf16x8 __attribute__((ext_vector_type(8)));
typedef float f32x4 __attribute__((ext_vector_type(4)));
typedef unsigned u32x4 __attribute__((ext_vector_type(4)));
typedef unsigned u32x2 __attribute__((ext_vector_type(2)));
constexpr int BM = 256, BK = 64, HALF = 128, HTB = HALF * BK * 2  , STAGE_BYTES = 8 * HTB, NXCD = 8, WGM = 4;

__host__ __device__ __forceinline__ int lds_byte(int r, int c) { const int st = (r >> 4) * 2 + (c >> 5), rr = r & 15, cc = c & 31, ob = rr * 64 + cc * 2; return st * 1024 + (ob ^ (((ob >> 9) & 1) << 5)); }
__host__ __device__ __forceinline__ void stage_rc(int b, int& R, int& C) { const int st = b / 1024, sb = b % 1024, swz = sb ^ (((sb >> 9) & 1) << 5); R = (st >> 1) * 16 + swz / 64; C = (st & 1) * 32 + (swz % 64) / 2; }
__host__ __device__ __forceinline__ int perm32(int rho) { const int n = rho >> 4, i = rho & 15; return 8 * (i >> 2) + 4 * n + (i & 3); }

struct Unit { int pm, pn, sel, par; };
struct HMap { const char* ga; const char* gb; const char* mg; const char* fq; };
constexpr size_t H_PANEL_BYTES = (size_t)256 * 2816 * 2, XSLICE8 = (size_t)8 << 20, XSLICE4 = (size_t)4 << 20;
static_assert(5 * H_PANEL_BYTES <= XSLICE8 && H_PANEL_BYTES <= XSLICE4, "hidden-tensor panels fit their slices");
__host__ __device__ __forceinline__ const char* hpanel(const HMap& h, int pm) { const int x = pm >> 4, p = pm & 15;
    return p < 5 ? h.ga + x * XSLICE8 + p * H_PANEL_BYTES : p < 10 ? h.gb + x * XSLICE8 + (p - 5) * H_PANEL_BYTES : p < 15 ? h.mg + x * XSLICE8 + (p - 10) * H_PANEL_BYTES : h.fq + x * XSLICE4; }
struct Gemm { const bf16_t* A; const bf16_t* Bt; int M, N, K; const bf16_t* A2; const bf16_t* Bt2; HMap hm = {nullptr, nullptr, nullptr, nullptr}; };

struct StaticOrder {
    int nM, nN, nwg, G, c;
    __host__ __device__ void init(int M, int N, int G_, int c_) { nM = M / BM; nN = N / BM; nwg = nM * nN; G = G_; c = c_; }
    __host__ __device__ bool next(int i, Unit& u) const {
        const long L = (long)i * G + c; if (L >= nwg) return false;
        int wgid = (int)L; { const int q = nwg / NXCD, r = nwg % NXCD, xcd = wgid % NXCD, off = wgid / NXCD; wgid = (xcd < r ? xcd * (q + 1) : r * (q + 1) + (xcd - r) * q) + off; }
        const int nig = WGM * nN, gid = wgid / nig, fm = gid * WGM, gsz = (nM - fm) < WGM ? (nM - fm) : WGM;
        u.pm = fm + ((wgid % nig) % gsz); u.pn = (wgid % nig) / gsz; u.sel = 0; return true;
    }
    __device__ __forceinline__ void a_ready(const Unit&) const {}
    __device__ __forceinline__ void done(const Unit&) const {}
};
struct PairOrder {
    StaticOrder so;
    __host__ __device__ bool next(int i, Unit& u) const { if (!so.next(i >> 1, u)) return false; u.sel = i & 1; return true; }
    __device__ __forceinline__ void a_ready(const Unit&) const {}
    __device__ __forceinline__ void done(const Unit&) const {}
};

__device__ __forceinline__ unsigned cvt_pk_bf16(float lo, float hi) { unsigned r; asm volatile("v_cvt_pk_bf16_f32 %0, %1, %2" : "=v"(r) : "v"(lo), "v"(hi)); return r; }
__device__ __forceinline__ u32x4 pack8(const f32x4 a, const f32x4 b) { u32x4 w; w.x = cvt_pk_bf16(a[0], a[1]); w.y = cvt_pk_bf16(a[2], a[3]); w.z = cvt_pk_bf16(b[0], b[1]); w.w = cvt_pk_bf16(b[2], b[3]); return w; }
__device__ __forceinline__ float bf_lo(unsigned w) { return __uint_as_float(w << 16); }
__device__ __forceinline__ float bf_hi(unsigned w) { return __uint_as_float(w & 0xffff0000u); }
constexpr int BF_LDS = 131072 + 512  , RSTD_LDS = 131072 + 1024, GAIN_LDS = RSTD_LDS + 2048;
constexpr int RSTAT_S = GAIN_LDS + 1024;
__device__ __forceinline__ void rowstat_dma(const float* ss, int pm, PG8_LAS unsigned char* lds, int wid, int lane) {
    const char* g = (const char*)(ss + (size_t)pm * BM * 16) + wid * 1024 + lane * 16;
#pragma unroll
    for (int i = 0; i < 2; ++i) __builtin_amdgcn_global_load_lds((const unsigned*)(g + i * 8192), (PG8_LAS unsigned*)(lds + RSTAT_S + wid * 1024 + i * 8192), 16, 0, 0);
}
__device__ __forceinline__ void rowstat_fold(PG8_LAS unsigned char* lds, int par, int tid) {
    const PG8_LAS f32x4* p = (const PG8_LAS f32x4*)(lds + RSTAT_S + (tid >> 1) * 64 + (tid & 1) * 32); const f32x4 a = p[0], b = p[1];
    float t = ((a[0] + a[1]) + (a[2] + a[3])) + ((b[0] + b[1]) + (b[2] + b[3]));
    t += __shfl_xor(t, 1);
    if ((tid & 1) == 0) *(PG8_LAS float*)(lds + RSTD_LDS + par * 1024 + 4 * (tid >> 1)) = __builtin_amdgcn_rsqf(t * (1.0f / 1024.0f) + 1e-6f);
}
__device__ __forceinline__ float rstd_lds(const PG8_LAS unsigned char* lds, int par, int rit) { return *(const PG8_LAS float*)(lds + RSTD_LDS + par * 1024 + 4 * rit); }
__device__ __forceinline__ float rstd_of(const float* p, int fq) { const f32x4 a = *(const f32x4*)(p + 4 * fq); float ss = (a[0] + a[1]) + (a[2] + a[3]);
    ss += __shfl_xor(ss, 16); ss += __shfl_xor(ss, 32);
    return __builtin_amdgcn_rsqf(ss * (1.0f / 1024.0f) + 1e-6f); }
__device__ __forceinline__ float sigmoid_f(float v) { return __builtin_amdgcn_rcpf(1.0f + __builtin_amdgcn_exp2f(-1.4426950408889634f * v)); }

template <bool NORMED> struct EpiGateUp {
    static constexpr bool PERM = true, AFTER_DRAIN = false, CHAIN = false, ROWSTAT = !NORMED;
    HMap hm; const float* ss; PG8_LAS unsigned char* lds;
    __device__ __forceinline__ void operator()(const f32x4 (&acc)[2][2][4][2], const Unit& u, int wr, int wc, int fr, int fq) const {
        const int row0 = u.pm * BM + wr * 64 + fr, col0 = u.pn * HALF + wc * 32 + 8 * fq;
#pragma unroll
        for (int ai = 0; ai < 2; ++ai)
#pragma unroll
            for (int m = 0; m < 4; ++m) { const int row = row0 + ai * HALF + m * 16; const float rs = NORMED ? 1.0f : rstd_lds(lds, u.par, wr * 64 + fr + ai * HALF + m * 16);
                f32x4 hv[2];
#pragma unroll
                for (int n = 0; n < 2; ++n) { const f32x4 g = acc[ai][0][m][n] * rs, up = acc[ai][1][m][n] * rs;
                    const f32x4 a = g * (-1.4426950408889634f); f32x4 ex;
#pragma unroll
                    for (int e = 0; e < 4; ++e) ex[e] = __builtin_amdgcn_exp2f(a[e]);
                    const f32x4 dn = ex + 1.0f; f32x4 rc;
#pragma unroll
                    for (int e = 0; e < 4; ++e) rc[e] = __builtin_amdgcn_rcpf(dn[e]);
                    hv[n] = (g * up) * rc; }
                __builtin_nontemporal_store(pack8(hv[0], hv[1]), (u32x4*)((bf16_t*)hpanel(hm, u.pm) + (size_t)(row - u.pm * BM) * 2816 + col0)); }
    }
};
template <bool BASE_B, bool WRITE_B, bool WRITE_F, int SCALE2> struct EpiRes {
    static constexpr bool PERM = true, AFTER_DRAIN = false, CHAIN = false, ROWSTAT = false;
    const float* basef; float* outf; bf16_t* XB; float* ssn;
    __device__ __forceinline__ void operator()(const f32x4 (&acc)[2][2][4][2], const Unit& u, int wr, int wc, int fr, int fq) const {
        const int row0 = u.pm * BM + wr * 64 + fr, col0 = u.pn * BM + wc * 32 + 8 * fq; constexpr float scale = 0.5f * SCALE2;
        u32x4 bw[2][4][2]; f32x4 bf0[2][4][2], bf1[2][4][2];
#define EPIRES_LOAD(ai) do { _Pragma("unroll") for (int m = 0; m < 4; ++m) _Pragma("unroll") for (int bj = 0; bj < 2; ++bj) { const size_t off = (size_t)(row0 + (ai) * HALF + m * 16) * 1024 + col0 + bj * HALF; \
            if (BASE_B) bw[ai][m][bj] = *(const u32x4*)(XB + off); else { bf0[ai][m][bj] = *(const f32x4*)(basef + off); bf1[ai][m][bj] = *(const f32x4*)(basef + off + 4); } } } while (0)
#define EPIRES_COMP(ai) do { _Pragma("unroll") for (int m = 0; m < 4; ++m) { float sq = 0.f; \
            _Pragma("unroll") for (int bj = 0; bj < 2; ++bj) { f32x4 b0, b1; \
                if (BASE_B) { const u32x4 w_ = bw[ai][m][bj]; b0 = (f32x4){bf_lo(w_.x), bf_hi(w_.x), bf_lo(w_.y), bf_hi(w_.y)}; b1 = (f32x4){bf_lo(w_.z), bf_hi(w_.z), bf_lo(w_.w), bf_hi(w_.w)}; } \
                else { b0 = bf0[ai][m][bj]; b1 = bf1[ai][m][bj]; } \
                const f32x4 o0 = b0 + acc[ai][bj][m][0] * scale, o1 = b1 + acc[ai][bj][m][1] * scale; ov0[m][bj] = o0; ov1[m][bj] = o1; \
                if (WRITE_B) sq += (o0[0] * o0[0] + o0[1] * o0[1]) + (o0[2] * o0[2] + o0[3] * o0[3]) + (o1[0] * o1[0] + o1[1] * o1[1]) + (o1[2] * o1[2] + o1[3] * o1[3]); } \
            if (WRITE_B) { sq += __shfl_xor(sq, 16); sq += __shfl_xor(sq, 32); } sqv[m] = sq; } } while (0)
#define EPIRES_STORE(ai) do { _Pragma("unroll") for (int m = 0; m < 4; ++m) { const int row = row0 + (ai) * HALF + m * 16; \
            _Pragma("unroll") for (int bj = 0; bj < 2; ++bj) { const size_t off = (size_t)row * 1024 + col0 + bj * HALF; \
                if (WRITE_F) { __builtin_nontemporal_store(ov0[m][bj], (f32x4*)(outf + off)); __builtin_nontemporal_store(ov1[m][bj], (f32x4*)(outf + off + 4)); } \
                if (WRITE_B) *(u32x4*)(XB + off) = pack8(ov0[m][bj], ov1[m][bj]); } \
            if (WRITE_B) { if (fq == 0) ssn[(size_t)row * 16 + u.pn * 4 + wc] = sqv[m]; } } } while (0)
        f32x4 ov0[4][2], ov1[4][2]; float sqv[4];
        EPIRES_LOAD(0); __builtin_amdgcn_sched_barrier(0);
        if (BASE_B) { EPIRES_LOAD(1); __builtin_amdgcn_sched_barrier(0); }
        EPIRES_COMP(0); __builtin_amdgcn_sched_barrier(0);
        if (!BASE_B) { EPIRES_LOAD(1); __builtin_amdgcn_sched_barrier(0); }
        EPIRES_STORE(0); __builtin_amdgcn_sched_barrier(0);
        EPIRES_COMP(1); __builtin_amdgcn_sched_barrier(0);
        EPIRES_STORE(1);
#undef EPIRES_LOAD
#undef EPIRES_COMP
#undef EPIRES_STORE
    }
};
struct EpiBranch {
    static constexpr bool PERM = true, AFTER_DRAIN = false, CHAIN = true, ROWSTAT = false;
    const bf16_t* GA; const bf16_t* GB; bf16_t* MG;
    __device__ __forceinline__ void operator()(f32x4 (&acc)[2][2][4][2], const Unit& u, int wr, int wc, int fr, int fq) const {
        const int row0 = u.pm * BM + wr * 64 + fr, col0 = u.pn * BM + wc * 32 + 8 * fq; const bf16_t* G = u.sel ? GB : GA;
        u32x4 gwv[2][4][2];
#pragma unroll
        for (int ai = 0; ai < 2; ++ai)
#pragma unroll
            for (int m = 0; m < 4; ++m)
#pragma unroll
                for (int bj = 0; bj < 2; ++bj) gwv[ai][m][bj] = *(const u32x4*)(G + (size_t)(row0 + ai * HALF + m * 16) * 1024 + col0 + bj * HALF);
        __builtin_amdgcn_sched_barrier(0);
#pragma unroll
        for (int ai = 0; ai < 2; ++ai)
#pragma unroll
            for (int m = 0; m < 4; ++m) { const size_t off = (size_t)(row0 + ai * HALF + m * 16) * 1024 + col0;
#pragma unroll
                for (int bj = 0; bj < 2; ++bj) { const u32x4 gw = gwv[ai][m][bj];
                    f32x4 v0 = acc[ai][bj][m][0], v1 = acc[ai][bj][m][1];
                    v0[0] *= bf_lo(gw.x); v0[1] *= bf_hi(gw.x); v0[2] *= bf_lo(gw.y); v0[3] *= bf_hi(gw.y); v1[0] *= bf_lo(gw.z); v1[1] *= bf_hi(gw.z); v1[2] *= bf_lo(gw.w); v1[3] *= bf_hi(gw.w);
                    if (u.sel) *(u32x4*)(MG + off + bj * HALF) = pack8(v0, v1);
                    else { acc[ai][bj][m][0] = v0; acc[ai][bj][m][1] = v1; } } }
    }
};
struct EpiWin {
    static constexpr bool PERM = true, AFTER_DRAIN = false, CHAIN = false, ROWSTAT = true;
    const float* ss; bf16_t *FQ, *FK, *FV, *DQ, *DK, *DV, *IQ, *IK, *GA, *GB; float* LOGF2; float* IWS;
    const float* bforget; PG8_LAS unsigned char* lds;
    __device__ __forceinline__ void operator()(const f32x4 (&acc)[2][2][4][2], const Unit& u, int wr, int wc, int fr, int fq) const {
        const int g = u.pn * 4 + wc; const int row0 = u.pm * BM + wr * 64 + fr;
        if (g == 43) {
#pragma unroll
            for (int ai = 0; ai < 2; ++ai)
#pragma unroll
                for (int m = 0; m < 4; ++m) { const int row = row0 + ai * HALF + m * 16; const float rs = rstd_lds(lds, u.par, wr * 64 + fr + ai * HALF + m * 16);
                    const f32x4 v0 = acc[ai][0][m][0] * rs, v1 = acc[ai][0][m][1] * rs;
                    if (fq == 0) { const int b = row >> 11, s = row & 2047;
#pragma unroll
                        for (int e = 0; e < 8; ++e) { const float z = (e < 4 ? v0[e & 3] : v1[e & 3]) + *(const PG8_LAS float*)(lds + BF_LDS + 4 * e);
                            const float t = __builtin_amdgcn_exp2f(-__builtin_fabsf(z) * LOG2E);
                            LOGF2[(size_t)(b * 8 + e) * SEQ + s] = __builtin_fminf(z, 0.f) * LOG2E - __builtin_amdgcn_logf(1.0f + t); } }
                    else if (fq == 1) { const float sc = 0.35355339059327373f * 0.125f;
                        *(f32x4*)(IWS + (size_t)row * 8) = v0 * sc; *(f32x4*)(IWS + (size_t)row * 8 + 4) = v1 * sc; } }
            return;
        }
        if (g >= 44) {
            const int cbg = (g - 44) * 32 + 8 * fq;
#pragma unroll
            for (int ai = 0; ai < 2; ++ai)
#pragma unroll
                for (int m = 0; m < 4; ++m) { const int row = row0 + ai * HALF + m * 16; const float rs = rstd_lds(lds, u.par, wr * 64 + fr + ai * HALF + m * 16);
                    f32x4 rr[2], sb[2];
#pragma unroll
                    for (int n = 0; n < 2; ++n)
#pragma unroll
                        for (int e = 0; e < 4; ++e) { float za = acc[ai][0][m][n][e] * rs, zb = acc[ai][1][m][n][e] * rs;
                            za = __builtin_fminf(__builtin_fmaxf(za, -30.f), 30.f); zb = __builtin_fminf(__builtin_fmaxf(zb, -30.f), 30.f);
                            const float ea = __builtin_amdgcn_exp2f(-1.4426950408889634f * za), eb = __builtin_amdgcn_exp2f(-1.4426950408889634f * zb);
                            sb[n][e] = __builtin_amdgcn_rcpf(1.0f + eb); rr[n][e] = (1.0f + eb) * __builtin_amdgcn_rcpf(1.0f + ea); }
                    __builtin_nontemporal_store(pack8(rr[0], rr[1]), (u32x4*)(GA + (size_t)row * 1024 + cbg)); __builtin_nontemporal_store(pack8(sb[0], sb[1]), (u32x4*)(GB + (size_t)row * 1024 + cbg)); }
            return;
        }
        int mode; bf16_t* dst; int pitch, cb; int gain = 0; float osc = 1.f;
        if (g < 8)       { mode = 1; dst = FQ; pitch = 512; cb = g * 64; gain = 0; osc = C2; }
        else if (g < 16) { mode = 1; dst = FK; pitch = 512; cb = (g - 8) * 64; gain = 1; }
        else if (g < 24) { mode = 0; dst = FV; pitch = 512; cb = (g - 16) * 64; }
        else if (g < 32) { mode = 1; dst = DQ; pitch = 512; cb = (g - 24) * 64; gain = 2; osc = C2; }
        else if (g == 32) { mode = 1; dst = DK; pitch = 64; cb = 0; gain = 3; }
        else if (g == 33) { mode = 0; dst = DV; pitch = 64; cb = 0; }
        else if (g < 42) { mode = 0; dst = IQ; pitch = 512; cb = (g - 34) * 64; }
        else             { mode = 0; dst = IK; pitch = 64; cb = 0; }
        f32x4 gv[2][2];
#pragma unroll
        for (int bj = 0; bj < 2; ++bj)
#pragma unroll
            for (int n = 0; n < 2; ++n) gv[bj][n] = (mode == 1) ? *(const PG8_LAS f32x4*)(lds + GAIN_LDS + 4 * (gain * 64 + 32 * bj + 8 * fq + 4 * n)) : (f32x4){1.f, 1.f, 1.f, 1.f};
#pragma unroll
        for (int ai = 0; ai < 2; ++ai)
#pragma unroll
            for (int m = 0; m < 4; ++m) { const int row = row0 + ai * HALF + m * 16; const float rs = rstd_lds(lds, u.par, wr * 64 + fr + ai * HALF + m * 16);
                f32x4 v[2][2]; float sq = 0.f;
#pragma unroll
                for (int bj = 0; bj < 2; ++bj)
#pragma unroll
                    for (int n = 0; n < 2; ++n) { v[bj][n] = acc[ai][bj][m][n] * rs; const f32x4 t = v[bj][n]; sq += (t[0] * t[0] + t[1] * t[1]) + (t[2] * t[2] + t[3] * t[3]); }
                if (mode == 1) { sq += __shfl_xor(sq, 16); sq += __shfl_xor(sq, 32); const float r = __builtin_amdgcn_rsqf(sq * (1.0f / 64.0f) + 1e-6f) * osc;
#pragma unroll
                    for (int bj = 0; bj < 2; ++bj)
#pragma unroll
                        for (int n = 0; n < 2; ++n) v[bj][n] = v[bj][n] * r * gv[bj][n]; }
                bf16_t* rowp = dst + (size_t)row * pitch + cb + 8 * fq;
#pragma unroll
                for (int bj = 0; bj < 2; ++bj) *(u32x4*)(rowp + 32 * bj) = pack8(v[bj][0], v[bj][1]); }
    }
};

template <class Epi, class Sched, bool ALIGN_EPI = false, bool SP2 = false>
__device__ __forceinline__ void gemm_phase(PG8_LAS unsigned char* lds, const Gemm g, const Sched& S, const Epi& E, const int wid, const int lane) {
    const int tid = wid * 64 + lane, wr = wid >> 2, wc = wid & 3, fr = lane & 15, fq = lane >> 4;
    const int K = g.K, nt = K / BK;
    unsigned voffA[2], voffB[2];
#pragma unroll
    for (int i = 0; i < 2; ++i) { int R, C; stage_rc(tid * 16 + i * 8192, R, C); const int Rb = Epi::PERM ? ((R & ~31) + perm32(R & 31)) : R;
        voffA[i] = (unsigned)(R * K + C) * 2u; voffB[i] = (unsigned)(Rb * K + C) * 2u; }
    const size_t kstep = (size_t)(BK * 2);
    const size_t hstep = (size_t)HALF * K * 2;
    const size_t tstep = 2 * hstep;
    const unsigned ldsw = (unsigned)wid * 1024u;
    const int aoff = lds_byte(wr * 64 + fr, fq * 8), boff = lds_byte(wc * 32 + fr, fq * 8);
#define PG8_SA(b, h) (((b) * 2 + (h)) * HTB)
#define PG8_SB(b, h) ((4 + (b) * 2 + (h)) * HTB)
#define PG8_STAGE(bufoff, gbase, voff) do { _Pragma("unroll") for (int _i = 0; _i < 2; ++_i) \
        __builtin_amdgcn_global_load_lds((const unsigned*)((const char*)(gbase) + (voff)[_i]), (PG8_LAS unsigned*)(lds + (bufoff) + ldsw + _i * 8192), 16, 0, 0); } while (0)
#define PG8_LDA(dst, b, h) do { _Pragma("unroll") for (int m = 0; m < 4; ++m) _Pragma("unroll") for (int k = 0; k < 2; ++k) dst[m][k] = *(const PG8_LAS bf16x8*)(lds + PG8_SA(b, h) + aoff + m * 2048 + k * 1024); } while (0)
#define PG8_LDB(dst, b, h) do { _Pragma("unroll") for (int n = 0; n < 2; ++n) _Pragma("unroll") for (int k = 0; k < 2; ++k) dst[n][k] = *(const PG8_LAS bf16x8*)(lds + PG8_SB(b, h) + boff + n * 2048 + k * 1024); } while (0)
#define PG8_MMA(ai, bj, At, Bt) do { __builtin_amdgcn_s_setprio(1); _Pragma("unroll") for (int m = 0; m < 4; ++m) _Pragma("unroll") for (int n = 0; n < 2; ++n) _Pragma("unroll") for (int k = 0; k < 2; ++k) \
        acc[ai][bj][m][n] = __builtin_amdgcn_mfma_f32_16x16x32_bf16(Bt[n][k], At[m][k], acc[ai][bj][m][n], 0, 0, 0); __builtin_amdgcn_s_setprio(0); } while (0)
#define PG8_MMAR(ai, bj, At, Bt) do { _Pragma("unroll") for (int m = 0; m < 4; ++m) _Pragma("unroll") for (int n = 0; n < 2; ++n) _Pragma("unroll") for (int k = 0; k < 2; ++k) \
        acc[ai][bj][m][n] = __builtin_amdgcn_mfma_f32_16x16x32_bf16(Bt[n][k], At[m][k], acc[ai][bj][m][n], 0, 0, 0); } while (0)
#define PG8_WAIT_V(n) asm volatile("s_waitcnt vmcnt(" #n ")" ::: "memory")
#define PG8_WAIT_L(n) asm volatile("s_waitcnt lgkmcnt(" #n ")" ::: "memory")
#define PG8_BAR __builtin_amdgcn_s_barrier()
#define PG8_SCHED __builtin_amdgcn_sched_barrier(0)
    Unit cur, nxt; int ui = 0;
    if (!S.next(0, cur)) return;
    f32x4 acc[2][2][4][2];
#pragma unroll
    for (int a = 0; a < 2; ++a)
#pragma unroll
        for (int b = 0; b < 2; ++b)
#pragma unroll
            for (int m = 0; m < 4; ++m)
#pragma unroll
                for (int n = 0; n < 2; ++n) acc[a][b][m][n] = (f32x4){0.f, 0.f, 0.f, 0.f};
    bf16x8 At[4][2], B0[2][2], B1[2][2];
    const char* cA = g.hm.ga ? hpanel(g.hm, cur.pm) : (const char*)(cur.sel ? g.A2 : g.A) + (size_t)cur.pm * tstep; const char* cB = (const char*)(cur.sel ? g.Bt2 : g.Bt) + (size_t)cur.pn * tstep;
    S.a_ready(cur);
    if constexpr (Epi::ROWSTAT) rowstat_dma(E.ss, cur.pm, lds, wid, lane);
    if constexpr (SP2) {
        PG8_STAGE(PG8_SB(0, 0), cB, voffB); PG8_STAGE(PG8_SB(0, 1), cB + hstep, voffB); PG8_STAGE(PG8_SA(0, 0), cA, voffA); PG8_STAGE(PG8_SA(0, 1), cA + hstep, voffA);
        if (wr == 1) PG8_BAR;
        PG8_WAIT_V(2); PG8_BAR;
        PG8_STAGE(PG8_SB(1, 0), cB + kstep, voffB); PG8_STAGE(PG8_SA(1, 0), cA + kstep, voffA); PG8_STAGE(PG8_SB(1, 1), cB + hstep + kstep, voffB);
        PG8_WAIT_V(6); PG8_BAR;
    } else {
        PG8_STAGE(PG8_SB(0, 0), cB, voffB); PG8_STAGE(PG8_SA(0, 0), cA, voffA); PG8_STAGE(PG8_SB(0, 1), cB + hstep, voffB); PG8_STAGE(PG8_SA(0, 1), cA + hstep, voffA);
        if (wr == 1) PG8_BAR;
        PG8_WAIT_V(4); PG8_BAR;
        PG8_STAGE(PG8_SB(1, 0), cB + kstep, voffB); PG8_STAGE(PG8_SA(1, 0), cA + kstep, voffA); PG8_STAGE(PG8_SB(1, 1), cB + hstep + kstep, voffB);
        PG8_WAIT_V(6); PG8_BAR;
    }
    if constexpr (Epi::ROWSTAT) rowstat_fold(lds, 0, tid);
    for (;;) {
        const bool has_next = S.next(ui + 1, nxt);
        const char* nA = has_next ? (g.hm.ga ? hpanel(g.hm, nxt.pm) : (const char*)(nxt.sel ? g.A2 : g.A) + (size_t)nxt.pm * tstep) : cA; const char* nB = has_next ? (const char*)(nxt.sel ? g.Bt2 : g.Bt) + (size_t)nxt.pn * tstep : cB;
        for (int t = 0; t < nt; t += 2) {
            const bool last = (t == nt - 2);
            const char* a1 = cA + (size_t)(t + 1) * kstep;
            const char* a2 = last ? nA : cA + (size_t)(t + 2) * kstep; const char* b2 = last ? nB : cB + (size_t)(t + 2) * kstep;
            const char* a3 = a2 + kstep; const char* b3 = b2 + kstep;
            if (last && has_next) { S.a_ready(nxt); if constexpr (Epi::ROWSTAT) rowstat_dma(E.ss, nxt.pm, lds, wid, lane); }
            if constexpr (SP2) {
            PG8_LDB(B0, 0, 0); PG8_LDB(B1, 0, 1); PG8_SCHED; PG8_LDA(At, 0, 0); PG8_STAGE(PG8_SA(1, 1), a1 + hstep, voffA);
            __builtin_amdgcn_s_setprio(1); PG8_WAIT_V(8); PG8_WAIT_L(0); PG8_BAR; PG8_MMAR(0, 0, At, B0); PG8_MMAR(0, 1, At, B1); __builtin_amdgcn_s_setprio(0); PG8_BAR; PG8_SCHED;
            PG8_LDA(At, 0, 1); PG8_STAGE(PG8_SB(0, 0), b2, voffB); PG8_STAGE(PG8_SB(0, 1), b2 + hstep, voffB); PG8_STAGE(PG8_SA(0, 0), a2, voffA);
            __builtin_amdgcn_s_setprio(1); PG8_WAIT_V(8); PG8_WAIT_L(0); PG8_BAR; PG8_MMAR(1, 0, At, B0); PG8_MMAR(1, 1, At, B1); __builtin_amdgcn_s_setprio(0); PG8_BAR; PG8_SCHED;
            PG8_LDB(B0, 1, 0); PG8_LDB(B1, 1, 1); PG8_SCHED; PG8_LDA(At, 1, 0); PG8_STAGE(PG8_SA(0, 1), a2 + hstep, voffA);
            __builtin_amdgcn_s_setprio(1); PG8_WAIT_V(8); PG8_WAIT_L(0); PG8_BAR; PG8_MMAR(0, 0, At, B0); PG8_MMAR(0, 1, At, B1); __builtin_amdgcn_s_setprio(0); PG8_BAR; PG8_SCHED;
            PG8_LDA(At, 1, 1); PG8_STAGE(PG8_SB(1, 0), b3, voffB); PG8_STAGE(PG8_SB(1, 1), b3 + hstep, voffB); PG8_STAGE(PG8_SA(1, 0), a3, voffA);
            __builtin_amdgcn_s_setprio(1); PG8_WAIT_V(8); PG8_WAIT_L(0); PG8_BAR; PG8_MMAR(1, 0, At, B0); PG8_MMAR(1, 1, At, B1); __builtin_amdgcn_s_setprio(0); PG8_BAR; PG8_SCHED;
            } else {
            PG8_LDB(B0, 0, 0); PG8_SCHED; PG8_LDA(At, 0, 0); PG8_STAGE(PG8_SA(1, 1), a1 + hstep, voffA);
            PG8_WAIT_L(8); PG8_BAR; PG8_WAIT_L(0); PG8_MMA(0, 0, At, B0); PG8_BAR; PG8_SCHED;
            PG8_LDB(B1, 0, 1); PG8_STAGE(PG8_SB(0, 0), b2, voffB);
            PG8_BAR; PG8_WAIT_L(0); PG8_MMA(0, 1, At, B1); PG8_BAR;
            PG8_LDA(At, 0, 1); PG8_STAGE(PG8_SA(0, 0), a2, voffA);
            PG8_BAR; PG8_WAIT_L(0); PG8_MMA(1, 0, At, B0); PG8_BAR; PG8_SCHED;
            PG8_STAGE(PG8_SB(0, 1), b2 + hstep, voffB);
            PG8_WAIT_V(6); PG8_BAR; PG8_MMA(1, 1, At, B1); PG8_BAR;
            PG8_LDB(B0, 1, 0); PG8_SCHED; PG8_LDA(At, 1, 0); PG8_STAGE(PG8_SA(0, 1), a2 + hstep, voffA);
            PG8_WAIT_L(8); PG8_BAR; PG8_WAIT_L(0); PG8_MMA(0, 0, At, B0); PG8_BAR; PG8_SCHED;
            PG8_LDB(B1, 1, 1); PG8_STAGE(PG8_SB(1, 0), b3, voffB);
            PG8_BAR; PG8_WAIT_L(0); PG8_MMA(0, 1, At, B1); PG8_BAR;
            PG8_LDA(At, 1, 1); PG8_STAGE(PG8_SA(1, 0), a3, voffA);
            PG8_BAR; PG8_WAIT_L(0); PG8_MMA(1, 0, At, B0); PG8_BAR; PG8_SCHED;
            PG8_STAGE(PG8_SB(1, 1), b3 + hstep, voffB);
            PG8_WAIT_V(6); PG8_BAR; PG8_MMA(1, 1, At, B1); PG8_BAR;
            }
        }
        if constexpr (ALIGN_EPI) { if (wr == 0) PG8_BAR; }
        cur.par = ui & 1;
        if constexpr (!Epi::AFTER_DRAIN) { E(acc, cur, wr, wc, fr, fq); S.done(cur); }
        if (!has_next) break;
        if constexpr (Epi::ROWSTAT) rowstat_fold(lds, (ui + 1) & 1, tid);
        if (!(Epi::CHAIN && cur.sel == 0)) {
#pragma unroll
        for (int a = 0; a < 2; ++a)
#pragma unroll
            for (int b = 0; b < 2; ++b)
#pragma unroll
                for (int m = 0; m < 4; ++m)
#pragma unroll
                    for (int n = 0; n < 2; ++n) acc[a][b][m][n] = (f32x4){0.f, 0.f, 0.f, 0.f};
        }
        cur = nxt; cA = nA; cB = nB; ++ui;
        if constexpr (ALIGN_EPI) { if (wr == 1) PG8_BAR; }
    }
    PG8_WAIT_V(0);
    if constexpr (!ALIGN_EPI) { if (wr == 0) PG8_BAR; }
    PG8_BAR;
    if constexpr (Epi::AFTER_DRAIN) { E.fused(acc, cur, wr, wc, fr, fq, lds, wid, lane); S.done(cur); }
#undef PG8_SA
#undef PG8_SB
#undef PG8_STAGE
#undef PG8_LDA
#undef PG8_LDB
#undef PG8_MMA
#undef PG8_MMAR
#undef PG8_WAIT_V
#undef PG8_WAIT_L
#undef PG8_BAR
#undef PG8_SCHED
}
}

constexpr int NWAVES = 8, NTHREADS = NWAVES * 64;
constexpr int NPHASE = 10;
constexpr int N_LAUNCHES = MK_N_LAUNCHES;
constexpr size_t MiB = 1u << 20, KiB = 1u << 10;
constexpr size_t WS_CTL = 0, CTL_ZERO_BYTES = 64 * KiB;
constexpr size_t WS_WGU1 = 1 * MiB, WS_WD1 = 12 * MiB, WS_WIN = 17 * MiB + 512 * KiB, WS_WA = 27 * MiB, WS_WB = 28 * MiB, WS_WOUT = 29 * MiB, WS_WGU2 = 31 * MiB, WS_WD2 = 42 * MiB;
constexpr size_t WS_XB = 48 * MiB;
constexpr size_t WS_SS = 488 * MiB;
constexpr size_t WS_LOGF = 112 * MiB + 512 * KiB, WS_CUM = 113 * MiB + 512 * KiB, WS_IW = 114 * MiB + 512 * KiB;
constexpr size_t WS_SEL = 116 * MiB;
constexpr size_t WS_FQ = 124 * MiB, WS_DQ = 156 * MiB, WS_FK = 188 * MiB, WS_FV = 220 * MiB, WS_IQ = 252 * MiB, WS_DK = 284 * MiB, WS_DV = 288 * MiB, WS_IK = 292 * MiB, WS_GA = 296 * MiB, WS_GB = 360 * MiB;
constexpr size_t WS_H = 124 * MiB;
constexpr size_t WS_MG = 424 * MiB, WS_END = 494 * MiB;
static_assert(WS_H + (size_t)TOK * DFF * 2 <= WS_MG && WS_GB + (size_t)TOK * DM * 2 <= WS_MG && WS_XB + (size_t)TOK * DM * 2 <= WS_LOGF && WS_SS + (size_t)3 * TOK * 64 <= WS_END, "ws map");
constexpr int CW_BAR = 4096;
constexpr int RING_BYTES = 131072, LDSCTL_OFF = RING_BYTES, MISC_OFF = LDSCTL_OFF + 320, LDS_BYTES = 155648;

#define GAS __attribute__((address_space(1)))
#define LAS __attribute__((address_space(3)))
typedef unsigned short bf16;
typedef unsigned v4u __attribute__((ext_vector_type(4)));
typedef unsigned v2u __attribute__((ext_vector_type(2)));
typedef float f32x4 __attribute__((ext_vector_type(4)));
typedef float f32x16 __attribute__((ext_vector_type(16)));
typedef short bf16x8 __attribute__((ext_vector_type(8)));
typedef short s16x4 __attribute__((ext_vector_type(4)));
typedef GAS unsigned gu32;
#define RLX_AGENT __ATOMIC_RELAXED, __HIP_MEMORY_SCOPE_AGENT
#define LDS_WAIT() asm volatile("s_waitcnt lgkmcnt(0)" ::: "memory")
#define VM_WAIT() asm volatile("s_waitcnt vmcnt(0)" ::: "memory")
__device__ __forceinline__ unsigned pkbf(float lo, float hi) { return pg8::cvt_pk_bf16(lo, hi); }

#define XB_TMO      128
#define XB_XCNT(j)  (256  + 64 * (j))
#define XB_XSUB(j)  (1280 + 64 * (j))
#define XB_XGEN(j)  (2304 + 64 * (j))
#define XB_TOP      3328
#define XB_TOPGEN   3392
#define XCD_BAR_WORDS 3456
#define XB_SPIN_CAP (1u << 20)
__device__ __forceinline__ unsigned xb_ld(unsigned* p)              { return __hip_atomic_load(p, __ATOMIC_RELAXED, __HIP_MEMORY_SCOPE_AGENT); }
__device__ __forceinline__ unsigned xb_add(unsigned* p, unsigned v) { return __hip_atomic_fetch_add(p, v, __ATOMIC_RELAXED, __HIP_MEMORY_SCOPE_AGENT); }
__device__ __forceinline__ unsigned xb_xcc_id() { return (unsigned)__builtin_amdgcn_s_getreg((3 << 11) | 20) & 0xFu; }
#define XB_SPIN(cond, bar) do { unsigned _sp = 0; while (cond) { __builtin_amdgcn_s_sleep(1); \
    if ((++_sp & 255u) == 0u) { if (xb_ld(&(bar)[XB_TMO])) break; if (_sp > XB_SPIN_CAP) { atomicAdd(&(bar)[XB_TMO], 1u); break; } } } } while (0)
__device__ __forceinline__ int fresh_lane() { int l; asm volatile("v_mbcnt_lo_u32_b32 %0, -1, 0\n\tv_mbcnt_hi_u32_b32 %0, -1, %0" : "=v"(l)); return l; }
struct XcdBarrier { unsigned* bar; unsigned x; volatile LAS unsigned* st; };
#define XL_SUB(j)  (4096 + 64 * (j))
#define XL_GEN(j)  (5120 + 64 * (j))
__device__ __forceinline__ XcdBarrier xcd_barrier_post(unsigned* bar, volatile LAS unsigned* st, bool t0) {
    XcdBarrier b; b.bar = bar; b.x = xb_xcc_id(); b.st = st;
    if (t0) { st[4] = xb_add(&bar[XB_XCNT(b.x)], 1u); st[5] = b.x; }
    return b;
}
__device__ __forceinline__ void xcd_barrier_complete(unsigned* bar, unsigned x, unsigned& nloc, unsigned& nx, unsigned& uni) {
    const unsigned G = gridDim.x * gridDim.y * gridDim.z;
    unsigned sum, cnt, mine, sp = 0u, low8;
    for (;;) {
        sum = 0u; cnt = 0u; mine = 0u; low8 = 0u;
#pragma unroll
        for (unsigned j = 0; j < 16; ++j) { const unsigned c = xb_ld(&bar[XB_XCNT(j)]); sum += c; cnt += (c > 0u) ? 1u : 0u; mine = (j == x) ? c : mine; low8 += (j < 8u && c * 8u == G) ? 1u : 0u; }
        if (sum == G) break;
        __builtin_amdgcn_s_sleep(1);
        if ((++sp & 255u) == 0u) { if (xb_ld(&bar[XB_TMO])) break; if (sp > XB_SPIN_CAP) { atomicAdd(&bar[XB_TMO], 1u); break; } }
    }
    nloc = mine > 0u ? mine : 1u; nx = cnt > 0u ? cnt : 1u;
    uni = (sum == G && cnt == 8u && low8 == 8u) ? 1u : 0u;
}
__device__ __forceinline__ void xcd_barrier(const XcdBarrier& b, bool t0) {
    asm volatile("s_waitcnt vmcnt(0)" ::: "memory");
    __syncthreads();
    if (t0) {
        unsigned* bar = b.bar;
        __builtin_amdgcn_s_waitcnt(0);
        unsigned nloc = b.st[0], nx = b.st[1];
        if (nloc == 0u) { unsigned uni; xcd_barrier_complete(bar, b.x, nloc, nx, uni); b.st[0] = nloc; b.st[1] = nx; b.st[6] = uni; }
        const unsigned old = xb_add(&bar[XB_XSUB(b.x)], 1u);
        const unsigned gen = old / nloc;
        if (old + 1u == (gen + 1u) * nloc) {
            __builtin_amdgcn_fence(__ATOMIC_RELEASE, "agent");
            asm volatile("s_waitcnt vmcnt(0)" ::: "memory");
            const unsigned og = xb_add(&bar[XB_TOP], 1u);
            const unsigned tg = og / nx;
            if (og + 1u == (tg + 1u) * nx) xb_add(&bar[XB_TOPGEN], 1u);
            else XB_SPIN(xb_ld(&bar[XB_TOPGEN]) == tg, bar);
            __builtin_amdgcn_fence(__ATOMIC_ACQUIRE, "agent");
            xb_add(&bar[XB_XGEN(b.x)], 1u);
            asm volatile("s_waitcnt vmcnt(0)" ::: "memory");
        } else {
            XB_SPIN(xb_ld(&bar[XB_XGEN(b.x)]) == gen, bar);
            __builtin_amdgcn_fence(__ATOMIC_ACQUIRE, "agent");
            asm volatile("s_waitcnt vmcnt(0)" ::: "memory");
        }
    }
    __syncthreads();
}

__device__ __forceinline__ void xcd_local_barrier(const XcdBarrier& b, bool t0) {
    asm volatile("s_waitcnt vmcnt(0)" ::: "memory");
    __syncthreads();
    if (t0) {
        unsigned* bar = b.bar; const unsigned nloc = b.st[0];
        const unsigned old = xb_add(&bar[XL_SUB(b.x)], 1u);
        const unsigned gen = old / nloc;
        const bool lastone = (old + 1u == (gen + 1u) * nloc);
        if (lastone) (void)xb_add(&bar[XL_GEN(b.x)], 1u);
        asm volatile("buffer_inv sc1" ::: "memory");
        if (!lastone) XB_SPIN(xb_ld(&bar[XL_GEN(b.x)]) == gen, bar);
        asm volatile("s_waitcnt vmcnt(0)" ::: "memory");
    }
    __syncthreads();
}

__device__ __forceinline__ float wave_sum(float v) {
#pragma unroll
    for (int o = 1; o < 64; o <<= 1) v += __shfl_xor(v, o);
    return v;
}
struct MapIdent { __device__ __forceinline__ int operator()(int c) const { return c; } };
struct MapGU { int up; __device__ __forceinline__ int operator()(int c) const { return (c >> 7) * 256 + up * 128 + (c & 127); } };
struct MapWin { __device__ __forceinline__ int operator()(int c) const {
    int g, d;
    if (c < 1536) { g = c >> 6; d = c & 63; }
    else if (c < 1544) { g = 43; d = c - 1536; }
    else if (c < 2056) { const int e = c - 1544; g = 24 + (e >> 6); d = e & 63; }
    else if (c < 2184) { const int e = c - 2056; g = 32 + (e >> 6); d = e & 63; }
    else if (c < 2696) { const int e = c - 2184; g = 34 + (e >> 6); d = e & 63; }
    else if (c < 2760) { g = 42; d = c - 2696; }
    else if (c < 2768) { g = 43; d = 8 + (c - 2760); }
    else if (c < 3792) { const int e = c - 2768; g = 44 + (e >> 5); d = e & 31; }
    else { const int e = c - 3792; g = 44 + (e >> 5); d = 32 + (e & 31); }
    return (g >> 2) * 256 + (d >> 5) * 128 + (g & 3) * 32 + (d & 31); } };
template <class Map>
__device__ __forceinline__ void p0_transpose_item(const float* W, int K, int N, const float* gain, bf16* WT, const Map map, LAS float* scr, int item, int lane) {
    const int nblk = (N + 31) / 32, kb = item / nblk, nb = item % nblk, k0 = 64 * kb, n0 = 32 * nb;
    const int c4 = (lane & 7) * 4, nc = n0 + c4; const bool ok = nc < N;
#pragma unroll
    for (int i = 0; i < 8; ++i) { const int kk = 8 * i + (lane >> 3);
        const f32x4 v = ok ? __builtin_nontemporal_load((const f32x4*)(W + (size_t)(k0 + kk) * N + nc)) : (f32x4){0.f, 0.f, 0.f, 0.f};
        LAS float* sp = scr + kk * 33 + c4; sp[0] = v[0]; sp[1] = v[1]; sp[2] = v[2]; sp[3] = v[3]; }
    LDS_WAIT(); asm volatile("" ::: "memory");
    const int c = lane & 7;
    f32x4 g0 = (f32x4){1.f, 1.f, 1.f, 1.f}, g1 = g0;
    if (gain) { g0 = *(const f32x4*)(gain + k0 + 8 * c); g1 = *(const f32x4*)(gain + k0 + 8 * c + 4); }
#pragma unroll
    for (int j = 0; j < 4; ++j) { const int n = (lane >> 3) + 8 * j; const LAS float* s = scr + (8 * c) * 33 + n;
        if (n0 + n < N) { v4u o; o.x = pkbf(s[0 * 33] * g0[0], s[1 * 33] * g0[1]); o.y = pkbf(s[2 * 33] * g0[2], s[3 * 33] * g0[3]); o.z = pkbf(s[4 * 33] * g1[0], s[5 * 33] * g1[1]); o.w = pkbf(s[6 * 33] * g1[2], s[7 * 33] * g1[3]);
            *(GAS v4u*)(WT + (size_t)map(n0 + n) * K + k0 + 8 * c) = o; } }
    LDS_WAIT(); asm volatile("" ::: "memory");
}
struct P0Args { const float *x, *n1, *wg1, *wu1, *wd1, *nm, *win, *wa, *wb, *wout, *n2, *wg2, *wu2, *wd2; bf16 *Wgu1, *Wd1, *Win, *Wa, *Wb, *Wout, *Wgu2, *Wd2, *XB; float* SS; };
__device__ __forceinline__ void p0_prologue(const P0Args& a, LAS unsigned char* lds, int vcu, int G, int wave, int lane) {
    LAS float* scr = (LAS float*)(lds + wave * 16384);
    const int gw = vcu * NWAVES + wave, NGW = G * NWAVES;
    constexpr int I_GU = (DM / 64) * (DFF / 32), I_D = (DFF / 64) * (DM / 32), I_IN = (DM / 64) * ((IN_W + 31) / 32), I_BR = (HW / 64) * (DM / 32), I_O = (DM / 64) * (DM / 32);
    constexpr int NITEMS = 6 * I_GU + I_IN + 2 * I_BR + I_O;
    static_assert(I_GU == I_D, "items");
    for (int it = gw; it < NITEMS; it += NGW) {
        int r = it;
        if (r < I_GU) { p0_transpose_item(a.wg1, DM, DFF, a.n1, a.Wgu1, MapGU{0}, scr, r, lane); continue; } r -= I_GU;
        if (r < I_GU) { p0_transpose_item(a.wu1, DM, DFF, a.n1, a.Wgu1, MapGU{1}, scr, r, lane); continue; } r -= I_GU;
        if (r < I_D)  { p0_transpose_item(a.wd1, DFF, DM, nullptr, a.Wd1, MapIdent{}, scr, r, lane); continue; } r -= I_D;
        if (r < I_GU) { p0_transpose_item(a.wg2, DM, DFF, a.n2, a.Wgu2, MapGU{0}, scr, r, lane); continue; } r -= I_GU;
        if (r < I_GU) { p0_transpose_item(a.wu2, DM, DFF, a.n2, a.Wgu2, MapGU{1}, scr, r, lane); continue; } r -= I_GU;
        if (r < I_D)  { p0_transpose_item(a.wd2, DFF, DM, nullptr, a.Wd2, MapIdent{}, scr, r, lane); continue; } r -= I_D;
        if (r < I_IN) { p0_transpose_item(a.win, DM, IN_W, a.nm, a.Win, MapWin{}, scr, r, lane); continue; } r -= I_IN;
        if (r < I_BR) { p0_transpose_item(a.wa, HW, DM, nullptr, a.Wa, MapIdent{}, scr, r, lane); continue; } r -= I_BR;
        if (r < I_BR) { p0_transpose_item(a.wb, HW, DM, nullptr, a.Wb, MapIdent{}, scr, r, lane); continue; } r -= I_BR;
        p0_transpose_item(a.wout, DM, DM, nullptr, a.Wout, MapIdent{}, scr, r, lane);
    }
    for (int i = gw; i < 48; i += NGW) { const int d = 16 + i, row = 10 * 256 + (d >> 5) * 128 + 96 + (d & 31);
        GAS v4u* p = (GAS v4u*)(a.Win + (size_t)row * DM) + lane; p[0] = (v4u){0u, 0u, 0u, 0u}; p[64] = (v4u){0u, 0u, 0u, 0u}; }
    for (int m = gw; m < TOK; m += NGW) {
        const GAS f32x4* xr = (const GAS f32x4*)(a.x + (size_t)m * DM) + lane; f32x4 v[4]; float s = 0.f;
#pragma unroll
        for (int j = 0; j < 4; ++j) { v[j] = __builtin_nontemporal_load(xr + 64 * j); s += (v[j].x * v[j].x + v[j].y * v[j].y) + (v[j].z * v[j].z + v[j].w * v[j].w); }
        s = wave_sum(s);
        const float rs = __builtin_amdgcn_rsqf(s * (1.0f / 1024.0f) + 1e-6f);
        GAS v2u* o8 = (GAS v2u*)(a.XB + (size_t)m * DM) + lane;
#pragma unroll
        for (int j = 0; j < 4; ++j) o8[64 * j] = (v2u){pkbf(v[j].x * rs, v[j].y * rs), pkbf(v[j].z * rs, v[j].w * rs)};
    }
}

__device__ __forceinline__ int crow(int r, int hi) { return (r & 3) + 8 * (r >> 2) + 4 * hi; }
__device__ __forceinline__ unsigned f2ord(float f) { const unsigned b = __float_as_uint(f); return (b & 0x80000000u) ? ~b : (b | 0x80000000u); }
#define MFMA32(a, b, c) __builtin_amdgcn_mfma_f32_32x32x16_bf16(a, b, c, 0, 0, 0)

__device__ __forceinline__ void cumsum_unit(LAS unsigned char* lds, const float* src, LAS float* dst, int tid, int wave, int lane) {
    asm volatile("" : "+v"(tid), "+v"(lane));
    LAS float* wsum = (LAS float*)lds;
    f32x4 v = *(const f32x4*)(src + 4 * tid);
    v.y += v.x; v.z += v.y; v.w += v.z;
    float t = v.w;
#pragma unroll
    for (int o = 1; o < 64; o <<= 1) { const float n = __shfl_up(t, o); if (lane >= o) t += n; }
    if (lane == 63) wsum[wave] = t;
    __syncthreads();
    float base = t - v.w;
    for (int w = 0; w < wave; ++w) base += wsum[w];
    *(LAS f32x4*)(dst + 4 * tid) = (f32x4){v.x + base, v.y + base, v.z + base, v.w + base};
    LDS_WAIT(); __syncthreads();
}

__device__ __forceinline__ void cnt4(unsigned& c0, unsigned& c1, unsigned& c2, unsigned& c3, unsigned a, unsigned b, unsigned c, unsigned d, unsigned C) {
    unsigned long long m0, m1, m2, m3;
    asm volatile("v_cmp_ge_u32_e64 %4, %8, %12\n\tv_cmp_ge_u32_e64 %5, %9, %12\n\tv_cmp_ge_u32_e64 %6, %10, %12\n\tv_cmp_ge_u32_e64 %7, %11, %12\n\t"
                 "v_addc_co_u32_e64 %0, vcc, 0, %0, %4\n\tv_addc_co_u32_e64 %1, vcc, 0, %1, %5\n\tv_addc_co_u32_e64 %2, vcc, 0, %2, %6\n\tv_addc_co_u32_e64 %3, vcc, 0, %3, %7"
                 : "+v"(c0), "+v"(c1), "+v"(c2), "+v"(c3), "=&s"(m0), "=&s"(m1), "=&s"(m2), "=&s"(m3) : "v"(a), "v"(b), "v"(c), "v"(d), "v"(C) : "vcc");
}
constexpr int IX_QI = 0, IX_HIST = 0  , IX_RED = 36864 - 4096, IX_GT = 36864, IX_EQ = IX_GT + 32 * 65 * 4, IX_NEED = IX_EQ + 32 * 65 * 4, IX_WQ = IX_NEED + 256, IX_RES = IX_WQ + 1024, IX_END = IX_RES + 512, IX_U = 57344  ;
static_assert(IX_END <= IX_U && IX_U + 65536 <= 122880, "indexer LDS map (the attention tables sit above it)");
static_assert(32 * 257 * 4 <= IX_RED + 4096, "histograms fit below the mask words");
__device__ __forceinline__ void idx_unit(LAS unsigned char* lds, int b, int qt, const bf16* IQ, const bf16* IK, const float* IWS, unsigned* SEL, int tid, int w, int lane) {
    asm volatile("" : "+v"(tid), "+v"(lane));
    const int r32 = lane & 31, hi = lane >> 5;
    const int q0 = qt * 32, nkt = qt + 1; const size_t rowq = (size_t)b * SEQ + q0;
    LAS unsigned* red = (LAS unsigned*)(lds + IX_RED); LAS unsigned* GT = (LAS unsigned*)(lds + IX_GT); LAS unsigned* EQm = (LAS unsigned*)(lds + IX_EQ); LAS unsigned* NEED = (LAS unsigned*)(lds + IX_NEED);
    const float wv_ = (tid < 256) ? IWS[rowq * 8 + tid] : 0.f;
    const char* kbase = (const char*)(IK + (size_t)b * SEQ * 64);
    unsigned koff = (unsigned)((w * 32 + r32) * 128 + hi * 16);
    bf16x8 kf0[4];
    if (w < nkt) {
#pragma unroll
        for (int ks = 0; ks < 4; ++ks) kf0[ks] = *(const bf16x8*)(kbase + koff + ks * 32); }
    { v4u qv[4];
#pragma unroll
      for (int i = 0; i < 4; ++i) { const int idx = tid + 512 * i, c = 2 * (idx >> 6) + ((idx >> 5) & 1), r = idx & 31; qv[i] = *(const GAS v4u*)(IQ + (rowq + r) * 512 + c * 8); }
      __builtin_amdgcn_sched_barrier(0);
#pragma unroll
      for (int i = 0; i < 4; ++i) { const int idx = tid + 512 * i, c = 2 * (idx >> 6) + ((idx >> 5) & 1), r = idx & 31; *(LAS v4u*)(lds + IX_QI + c * 512 + r * 16) = qv[i]; } }
    LAS float* wql = (LAS float*)(lds + IX_WQ);
    if (tid < 256) wql[(tid & 7) * 32 + (tid >> 3)] = wv_;
    if (tid < 32) { LAS unsigned* RESi = (LAS unsigned*)(lds + IX_RES); RESi[tid * 4 + 0] = 0u; RESi[tid * 4 + 1] = (unsigned)TOPK; RESi[tid * 4 + 2] = 0u; }
    LDS_WAIT(); __syncthreads();
    unsigned u[6][16];
    LAS unsigned char* uw = lds + IX_U + w * 8192 + lane * 16;
    const LAS unsigned char* qb = lds + IX_QI + hi * 512 + r32 * 16;
    {
    bf16x8 kf[2][4];
#pragma unroll
    for (int ks = 0; ks < 4; ++ks) kf[0][ks] = kf0[ks];
    bf16x8 qa[4], qc[4];
#define IDX_SB __builtin_amdgcn_sched_barrier(0)
#define IDX_QREAD(dst, h_) do { _Pragma("unroll") for (int ks = 0; ks < 4; ++ks) dst[ks] = *(const LAS bf16x8*)(qb + ((h_) * 4 + ks) * 1024); } while (0)
#define IDX_VALU4(accP, wP, g_) do { _Pragma("unroll") for (int e = 0; e < 4; ++e) { int xi = __float_as_int(accP[4 * (g_) + e]); xi = xi > 0 ? xi : 0; float o_; \
        asm("v_fma_f32 %0, %1, %2, %3" : "=v"(o_) : "v"(wP), "v"(xi), "v"(sc[4 * (g_) + e])); sc[4 * (g_) + e] = o_; } } while (0)
#define IDX_STAGE(accN, qN, accP, hP) do { const float wP_ = wql[(hP) * 32 + r32]; IDX_SB; \
        accN = MFMA32(kf[j & 1][0], qN[0], f32x16{}); IDX_SB; IDX_VALU4(accP, wP_, 0); IDX_SB; \
        accN = MFMA32(kf[j & 1][1], qN[1], accN); IDX_SB; IDX_VALU4(accP, wP_, 1); IDX_SB; \
        accN = MFMA32(kf[j & 1][2], qN[2], accN); IDX_SB; IDX_VALU4(accP, wP_, 2); IDX_SB; \
        accN = MFMA32(kf[j & 1][3], qN[3], accN); IDX_SB; IDX_VALU4(accP, wP_, 3); IDX_SB; } while (0)
    IDX_QREAD(qa, 0); IDX_QREAD(qc, 1);
#pragma unroll
    for (int j = 0; j < 8; ++j) {
        const int kt = w + 8 * j;
        if (kt < nkt) {
            f32x16 sc = f32x16{}, accA = f32x16{}, accB;
#pragma unroll
            for (int ks = 0; ks < 4; ++ks) accA = MFMA32(kf[j & 1][ks], qa[ks], accA);
            IDX_SB;
            if (j < 7 && kt + 8 < nkt) { asm volatile("" : "+v"(koff)); const char* kp = kbase + koff + (j + 1) * 32768;
#pragma unroll
                for (int ks = 0; ks < 4; ++ks) kf[(j + 1) & 1][ks] = *(const bf16x8*)(kp + ks * 32); }
            IDX_SB; IDX_QREAD(qa, 2); IDX_SB; IDX_STAGE(accB, qc, accA, 0);
            IDX_QREAD(qc, 3); IDX_SB; IDX_STAGE(accA, qa, accB, 1);
            IDX_QREAD(qa, 4); IDX_SB; IDX_STAGE(accB, qc, accA, 2);
            IDX_QREAD(qc, 5); IDX_SB; IDX_STAGE(accA, qa, accB, 3);
            IDX_QREAD(qa, 6); IDX_SB; IDX_STAGE(accB, qc, accA, 4);
            IDX_QREAD(qc, 7); IDX_SB; IDX_STAGE(accA, qa, accB, 5);
            IDX_QREAD(qa, 0); IDX_SB; IDX_STAGE(accB, qc, accA, 6);
            IDX_QREAD(qc, 1); IDX_SB;
            { const float wL_ = wql[7 * 32 + r32]; IDX_VALU4(accB, wL_, 0); IDX_VALU4(accB, wL_, 1); IDX_VALU4(accB, wL_, 2); IDX_VALU4(accB, wL_, 3); }
            const bool diag = (kt == qt);
            unsigned o[16];
#pragma unroll
            for (int r = 0; r < 16; ++r) { o[r] = f2ord(sc[r]); if (diag && crow(r, hi) > r32) o[r] = 0u; }
            if (j < 6) {
#pragma unroll
                for (int r = 0; r < 16; ++r) u[j < 6 ? j : 0][r] = o[r];
            } else {
#pragma unroll
                for (int r4 = 0; r4 < 4; ++r4) *(LAS v4u*)(uw + (j - 6) * 4096 + r4 * 1024) = (v4u){o[4 * r4], o[4 * r4 + 1], o[4 * r4 + 2], o[4 * r4 + 3]};
            }
        } else if (j < 6) {
#pragma unroll
            for (int r = 0; r < 16; ++r) u[j < 6 ? j : 0][r] = 0u;
        }
    }
#undef IDX_QREAD
#undef IDX_STAGE
#undef IDX_VALU4
#undef IDX_SB
    }
#define IDX_UKEYS(j_, uk) unsigned uk[16]; if ((j_) < 6) { _Pragma("unroll") for (int r = 0; r < 16; ++r) uk[r] = u[(j_) < 6 ? (j_) : 0][r]; } else { _Pragma("unroll") for (int r4 = 0; r4 < 4; ++r4) { const v4u t_ = *(const LAS v4u*)(uw + ((j_) - 6) * 4096 + r4 * 1024); uk[4 * r4] = t_.x; uk[4 * r4 + 1] = t_.y; uk[4 * r4 + 2] = t_.z; uk[4 * r4 + 3] = t_.w; } }
    const unsigned nvalid = (unsigned)(q0 + r32 + 1);
    LAS unsigned* HIST = (LAS unsigned*)(lds + IX_HIST); LAS unsigned* RES = (LAS unsigned*)(lds + IX_RES);
    unsigned tp = 0u, rank = (unsigned)TOPK, cnteq = 0u;
    const bool anysel = __any(nvalid > (unsigned)TOPK);
    if (anysel) {
        __syncthreads();
#pragma unroll 1
        for (int ps = 0; ps < 4; ++ps) {
            const int sft = 24 - 8 * ps;
            for (int i = tid; i < 32 * 257; i += NTHREADS) HIST[i] = 0u;
            LDS_WAIT(); __syncthreads();
            { const unsigned pf = tp >> sft; LAS unsigned* hq = HIST + r32 * 257;
#pragma unroll
              for (int j = 0; j < 8; ++j) if (w + 8 * j < nkt) { IDX_UKEYS(j, uk)
#pragma unroll
                  for (int r = 0; r < 16; ++r) { unsigned d = (uk[r] >> sft) - pf; d = d < 256u ? d : 256u; (void)__hip_atomic_fetch_add(hq + d, 1u, __ATOMIC_RELAXED, __HIP_MEMORY_SCOPE_WORKGROUP); } } }
            LDS_WAIT(); __syncthreads();
            {
              const int g = lane >> 4, i16 = lane & 15, q = 4 * w + g; const LAS unsigned* hq = HIST + q * 257 + (240 - 16 * i16);
              unsigned hv[16], sl = 0u;
#pragma unroll
              for (int k = 0; k < 16; ++k) { hv[k] = hq[k]; sl += hv[k]; }
              unsigned inc = sl;
#pragma unroll
              for (int o = 1; o < 16; o <<= 1) { const unsigned n = (unsigned)__shfl_up((int)inc, o, 16); if (i16 >= o) inc += n; }
              const unsigned exc = inc - sl;
              const unsigned rk = RES[q * 4 + 1];
              if (exc < rk && rk <= inc) { unsigned above = exc, bsel = 0u, bcnt = 0u; bool found = false;
#pragma unroll
                  for (int k = 15; k >= 0; --k) { if (!found) { if (rk <= above + hv[k]) { found = true; bsel = (unsigned)(240 - 16 * i16 + k); bcnt = hv[k]; } else above += hv[k]; } }
                  RES[q * 4 + 0] = RES[q * 4 + 0] | (bsel << sft); RES[q * 4 + 1] = rk - above; RES[q * 4 + 2] = bcnt; } }
            LDS_WAIT(); __syncthreads();
            tp = RES[r32 * 4 + 0]; rank = RES[r32 * 4 + 1]; cnteq = RES[r32 * 4 + 2];
            if (__all(nvalid <= (unsigned)TOPK || rank == cnteq)) break;
        }
    }
    bool tie = (nvalid > (unsigned)TOPK) && (rank != cnteq); bool done = !tie;
    const unsigned P = (nvalid > (unsigned)TOPK) ? tp : 1u;
    const unsigned need = tie ? rank : 0u;
    const bool anynd = __any(tie);
    const bool useeq = tie;
#pragma unroll
    for (int j = 0; j < 8; ++j) { const int kt = w + 8 * j;
        if (kt < nkt) { unsigned gtw = 0u, eqw = 0u; IDX_UKEYS(j, uk)
#pragma unroll
            for (int r = 0; r < 16; ++r) { const int cb = (r & 3) + 8 * (r >> 2); const unsigned v = uk[r];
                const bool sg = done ? (v >= P) : (v > P); const bool se = useeq && (v == P);
                gtw |= (sg ? 1u : 0u) << cb; eqw |= (se ? 1u : 0u) << cb; }
            gtw <<= 4 * hi; eqw <<= 4 * hi;
            gtw |= __shfl_xor(gtw, 32); eqw |= __shfl_xor(eqw, 32);
            if (lane < 32) { GT[r32 * 65 + kt] = gtw; EQm[r32 * 65 + kt] = eqw; } } }
    if (w == 0 && lane < 32) NEED[lane] = need;
    LDS_WAIT(); __syncthreads();
    if (anynd) {
        if (tid < 32) { unsigned rem = NEED[tid];
            for (int kt = 0; kt < nkt; ++kt) { unsigned e = EQm[tid * 65 + kt]; const unsigned c = (unsigned)__popc(e);
                if (c > rem) { while ((unsigned)__popc(e) > rem) e &= ~(0x80000000u >> __clz(e)); EQm[tid * 65 + kt] = e; }
                rem -= (unsigned)__popc(e); } }
        LDS_WAIT(); __syncthreads();
    }
}

constexpr int AT_KSLOT = 8448, AT_KCH = 1040;
constexpr int AT_K = 0, AT_V = 2 * AT_KSLOT, AT_M = AT_V + 16384, AT_CUM = AT_M + 8192, AT_WS = AT_CUM + 8192, AT_OST = AT_WS + 2048, AT_FLG = AT_OST + NWAVES * 4096, AT_SEL = AT_FLG + 64, AT_END = AT_SEL + 32 * 65 * 4;
constexpr int AT_LUT = 122880, LUTW = 240, AT_QKB = AT_LUT + 8 * LUTW * 4;
static_assert(AT_END <= AT_LUT && AT_QKB + 64 <= 131072, "attention LDS map");
constexpr float ATT_THR = 20.0f;
__device__ __forceinline__ int t5_bucket(int rel) {
    if (rel < 16) return rel;
    int b = 15;
    constexpr int th[16] = {16, 19, 21, 24, 27, 31, 35, 40, 46, 52, 59, 67, 77, 87, 99, 113};
#pragma unroll
    for (int i = 0; i < 16; ++i) b += (rel >= th[i]) ? 1 : 0;
    return b;
}
typedef short v4i16_t __attribute__((ext_vector_type(4)));
__device__ __forceinline__ s16x4 vtr(const LAS unsigned char* p) { return __builtin_bit_cast(s16x4, __builtin_amdgcn_ds_read_tr16_b64_v4i16((LAS v4i16_t*)p)); }
__device__ __forceinline__ float max3f(float a, float b, float c) { float r; asm("v_max3_f32 %0, %1, %2, %3" : "=v"(r) : "v"(a), "v"(b), "v"(c)); return r; }
__device__ __forceinline__ float rowmax32(const f32x16& p0, const f32x16& p1) {
    float a = max3f(p0[0], p0[1], p1[0]), c = max3f(p0[2], p0[3], p1[1]); a = max3f(a, p1[2], p1[3]);
#pragma unroll
    for (int r = 4; r < 16; r += 4) { a = max3f(a, p0[r], p0[r + 1]); c = max3f(c, p0[r + 2], p0[r + 3]); a = max3f(a, p1[r], p1[r + 1]); c = max3f(c, p1[r + 2], p1[r + 3]); }
    a = __builtin_fmaxf(a, c);
    return __builtin_fmaxf(a, __shfl_xor(a, 32));
}
template <bool SREF>
__device__ __forceinline__ void softmax_pv(f32x16& p0, f32x16& p1, float& mref, f32x16& lacc, f32x16 (&o)[2], LAS float* wsf, const LAS unsigned char* vslot, int lane, int r32, int hi) {
    if (!SREF) {
    asm volatile("s_nop 13" : "+v"(p0), "+v"(p1));
    const float rm = rowmax32(p0, p1);
    if (__any(rm > ATT_THR)) {
        const float dl = rm > 0.f ? rm : 0.f, f = __builtin_amdgcn_exp2f(-dl);
        mref += dl;
        if (hi == 0) wsf[r32] = f;
#pragma unroll
        for (int r = 0; r < 16; ++r) { p0[r] -= dl; p1[r] -= dl; }
        LDS_WAIT();
        const LAS float* wsf4 = wsf + 4 * hi;
#pragma unroll
        for (int r = 0; r < 16; ++r) { const float a = wsf4[(r & 3) + 8 * (r >> 2)]; o[0][r] *= a; o[1][r] *= a; lacc[r] *= a; }
    }
    }
    const LAS unsigned char* vp = vslot + ((lane >> 4) & 1) * 32 + (lane & 3) * 8 + (4 * hi + ((lane & 15) >> 2)) * 64;
    s16x4 vlo[8], vhh[8];
#pragma unroll
    for (int i = 0; i < 8; ++i) { vlo[i] = vtr(vp + (i >> 2) * 4096 + (i & 3) * 1024); vhh[i] = vtr(vp + (i >> 2) * 4096 + (i & 3) * 1024 + 512); }
    __builtin_amdgcn_sched_barrier(0);
#pragma unroll
    for (int r = 0; r < 16; ++r) { p0[r] = __builtin_amdgcn_exp2f(p0[r]); p1[r] = __builtin_amdgcn_exp2f(p1[r]); }
    v4u pw[4];
    pw[0] = (v4u){pkbf(p0[0], p0[1]), pkbf(p0[2], p0[3]), pkbf(p0[4], p0[5]), pkbf(p0[6], p0[7])};
    pw[1] = (v4u){pkbf(p0[8], p0[9]), pkbf(p0[10], p0[11]), pkbf(p0[12], p0[13]), pkbf(p0[14], p0[15])};
    pw[2] = (v4u){pkbf(p1[0], p1[1]), pkbf(p1[2], p1[3]), pkbf(p1[4], p1[5]), pkbf(p1[6], p1[7])};
    pw[3] = (v4u){pkbf(p1[8], p1[9]), pkbf(p1[10], p1[11]), pkbf(p1[12], p1[13]), pkbf(p1[14], p1[15])};
    __builtin_amdgcn_sched_barrier(0);
#pragma unroll
    for (int i = 0; i < 8; ++i) { const bf16x8 vf = (bf16x8){vlo[i][0], vlo[i][1], vlo[i][2], vlo[i][3], vhh[i][0], vhh[i][1], vhh[i][2], vhh[i][3]};
        o[i >> 2] = MFMA32(__builtin_bit_cast(bf16x8, pw[i & 3]), vf, o[i >> 2]); }
    const bf16x8 ones = (bf16x8){(short)0x3f80, (short)0x3f80, (short)0x3f80, (short)0x3f80, (short)0x3f80, (short)0x3f80, (short)0x3f80, (short)0x3f80};
#pragma unroll
    for (int i = 0; i < 4; ++i) lacc = MFMA32(__builtin_bit_cast(bf16x8, pw[i]), ones, lacc);
}
__device__ __forceinline__ void attn_store(const f32x16& lacc, const f32x16 (&o)[2], LAS float* wsf, LAS bf16* stg, bf16* Ow, int lane, int r32, int hi) {
    LAS bf16* stg4 = stg + (4 * hi) * 64 + r32;
#pragma unroll
    for (int r = 0; r < 16; ++r) { const int oc = (r & 3) + 8 * (r >> 2); const float rl = __builtin_amdgcn_rcpf(lacc[r]);
        const unsigned a = pkbf(o[0][r] * rl, 0.f), c = pkbf(o[1][r] * rl, 0.f);
        stg4[oc * 64] = (bf16)(a & 0xffffu); stg4[oc * 64 + 32] = (bf16)(c & 0xffffu); }
    LDS_WAIT();
#pragma unroll
    for (int i = 0; i < 4; ++i) { const int row = i * 8 + (lane >> 3), ch = lane & 7; const v4u v = *(const LAS v4u*)(stg + row * 64 + ch * 8); *(GAS v4u*)(Ow + (size_t)row * 512 + ch * 8) = v; }
}

template <bool SREF>
__device__ __forceinline__ void fox_unit(LAS unsigned char* lds, int b, int h, int qblk, const bf16* Q, const bf16* K, const bf16* V, bf16* O, const float* CUM2, int tid, int w, int lane) {
    asm volatile("" : "+v"(tid), "+v"(lane));
    constexpr int KP = 512;
    const int r32 = lane & 31, hi = lane >> 5;
    const int q0u = 256 * qblk, q0w = q0u + 32 * w, NT = 4 * (qblk + 1);
    const size_t rowb = (size_t)b * SEQ;
    const bf16* Kb = K + rowb * KP + h * 64; const bf16* Vb = V + rowb * KP + h * 64;
    LAS float* wsf = (LAS float*)(lds + AT_WS) + w * 64;
    LAS float* cums = (LAS float*)(lds + AT_CUM);
    const int kc = tid & 7, krow = tid >> 3; const bf16* ksrc = Kb + (size_t)krow * KP + kc * 8; const int kdst = AT_K + kc * AT_KCH + krow * 16;
    const int vrow = tid >> 3, vdh = (tid >> 2) & 1, vq4 = tid & 3; const bf16* vsrc = Vb + (size_t)vrow * KP + vdh * 32 + vq4 * 8; const int vdst = AT_V + vdh * 4096 + vrow * 64 + vq4 * 16;
    v4u kreg = *(const GAS v4u*)(ksrc + (size_t)(NT - 1) * 64 * KP), vreg = *(const GAS v4u*)(vsrc + (size_t)(NT - 1) * 64 * KP);
    v4u kreg2 = (v4u){0u, 0u, 0u, 0u}, vreg2 = kreg2;
    if (NT > 1) { kreg2 = *(const GAS v4u*)(ksrc + (size_t)(NT - 2) * 64 * KP); vreg2 = *(const GAS v4u*)(vsrc + (size_t)(NT - 2) * 64 * KP); }
    LAS unsigned* flg = (LAS unsigned*)(lds + AT_FLG);
    if (tid < 16) flg[tid] = 0u;
    const float qkb = *(const LAS float*)(lds + AT_QKB);
    bf16x8 qr[4];
    { const bf16* Qw = Q + (rowb + q0w + r32) * 512 + h * 64 + hi * 8;
#pragma unroll
      for (int d0 = 0; d0 < 4; ++d0) qr[d0] = *(const bf16x8*)(Qw + d0 * 16); }
    const float cq = cums[q0w + r32];
    *(LAS v4u*)(lds + kdst) = kreg; *(LAS v4u*)(lds + vdst) = vreg;
    float mref = -qkb; f32x16 l = f32x16{}; f32x16 o[2]; o[0] = f32x16{}; o[1] = f32x16{};
    bool wdone = false;
    LDS_WAIT(); __syncthreads();
    asm volatile("" : "+v"(qr[0]), "+v"(qr[1]), "+v"(qr[2]), "+v"(qr[3]));
    auto step = [&](const int it, v4u& kL, v4u& vL, const v4u& kW, const v4u& vW) __attribute__((always_inline)) -> bool {
        const int t = NT - 1 - it; const int slot = (it & 1) * 8192;
        if (t > 1) { kL = *(const GAS v4u*)(ksrc + (size_t)(t - 2) * 64 * KP); vL = *(const GAS v4u*)(vsrc + (size_t)(t - 2) * 64 * KP); }
        if ((64 * t <= q0w + 31) && !wdone) {
            f32x16 p0, p1; const float e0 = cq - mref;
            { const LAS float* ck = cums + 64 * t + 4 * hi;
#pragma unroll
              for (int g = 0; g < 4; ++g) { const f32x4 c0 = *(const LAS f32x4*)(ck + 8 * g), c1 = *(const LAS f32x4*)(ck + 32 + 8 * g);
#pragma unroll
                  for (int e = 0; e < 4; ++e) { p0[4 * g + e] = e0 - c0[e]; p1[4 * g + e] = e0 - c1[e]; } } }
            const LAS unsigned char* kb = lds + AT_K + (it & 1) * AT_KSLOT + hi * AT_KCH + r32 * 16;
            bf16x8 kfr[8];
#pragma unroll
            for (int d0 = 0; d0 < 4; ++d0) { kfr[2 * d0] = *(const LAS bf16x8*)(kb + d0 * (2 * AT_KCH)); kfr[2 * d0 + 1] = *(const LAS bf16x8*)(kb + d0 * (2 * AT_KCH) + 512); }
            __builtin_amdgcn_sched_barrier(0);
#pragma unroll
            for (int d0 = 0; d0 < 4; ++d0) { p0 = MFMA32(kfr[2 * d0], qr[d0], p0); p1 = MFMA32(kfr[2 * d0 + 1], qr[d0], p1); }
            if (64 * t + 63 > q0w) { const int qa = q0w + r32, kb0 = 64 * t + 4 * hi;
#pragma unroll
                for (int r = 0; r < 16; ++r) { const int kv = kb0 + (r & 3) + 8 * (r >> 2); if (kv > qa) p0[r] = NEGBIG; if (kv + 32 > qa) p1[r] = NEGBIG; } }
            softmax_pv<SREF>(p0, p1, mref, l, o, wsf, lds + AT_V + slot, lane, r32, hi);
        }
        if (t > 0) { const int ns = ((it + 1) & 1) * 8192, nk = ((it + 1) & 1) * AT_KSLOT; *(LAS v4u*)(lds + kdst + nk) = kW; *(LAS v4u*)(lds + vdst + ns) = vW; }
        if (!wdone && t > 0 && (64 * t <= q0w + 31)) { const float cend = cums[64 * t - 1]; wdone = __all((qkb + cq - cend - mref) < -150.0f); }
        if (lane == 0) flg[(it & 1) * 8 + w] = wdone ? 1u : 0u;
        LDS_WAIT(); __syncthreads();
        const LAS v4u* fp = (const LAS v4u*)(flg + (it & 1) * 8); const v4u f0 = fp[0], f1 = fp[1];
        return (f0.x & f0.y & f0.z & f0.w & f1.x & f1.y & f1.z & f1.w) != 0u;
    };
    for (int it = 0; it < NT; it += 2) {
        if (step(it, kreg, vreg, kreg2, vreg2)) break;
        if (it + 1 < NT) { if (step(it + 1, kreg2, vreg2, kreg, vreg)) break; }
    }
    attn_store(l, o, wsf, (LAS bf16*)(lds + AT_OST) + w * 2048, O + (rowb + q0w) * 512 + h * 64, lane, r32, hi);
    LDS_WAIT(); __syncthreads();
}

template <bool SREF>
__device__ __forceinline__ void dsa_unit(LAS unsigned char* lds, int b, int qt, const bf16* Q, const bf16* K, const bf16* V, bf16* O, const unsigned* SEL, int tid, int w, int lane) {
    asm volatile("" : "+v"(tid), "+v"(lane));
    constexpr int KP = 64;
    const int r32 = lane & 31, hi = lane >> 5;
    const int q0w = 32 * qt, NT = (qt + 2) >> 1;
    const size_t rowb = (size_t)b * SEQ;
    const bf16* Kb = K + rowb * KP; const bf16* Vb = V + rowb * KP;
    LAS float* wsf = (LAS float*)(lds + AT_WS) + w * 64;
    const LAS float* lut = (const LAS float*)(lds + AT_LUT) + w * LUTW + 64;
    const int kc = tid & 7, krow = tid >> 3; const bf16* ksrc = Kb + (size_t)krow * KP + kc * 8; const int kdst = AT_K + kc * AT_KCH + krow * 16;
    const int vrow = tid >> 3, vdh = (tid >> 2) & 1, vq4 = tid & 3; const bf16* vsrc = Vb + (size_t)vrow * KP + vdh * 32 + vq4 * 8; const int vdst = AT_V + vdh * 4096 + vrow * 64 + vq4 * 16;
    const int mf = tid >> 1, mpart = tid & 1, mhh = mf >> 7, mks = (mf >> 6) & 1, mL = mf & 63, mq = mL & 31, mhi = mL >> 5;
    const int msh = 8 * (2 * mks + mpart) + 4 * mhi; const int mdst = AT_M + ((mhh * 2 + mks) * 64 + mL) * 16 + mpart * 8;
    LAS unsigned* selc = (LAS unsigned*)(lds + AT_SEL);
    { const int sr = tid >> 4, sc = (tid & 15) * 4; const LAS unsigned* gtw = (const LAS unsigned*)(lds + IX_GT) + sr * 65 + sc; const LAS unsigned* eqw = (const LAS unsigned*)(lds + IX_EQ) + sr * 65 + sc;
      LAS unsigned* d = selc + sr * 65 + sc;
#pragma unroll
      for (int k = 0; k < 4; ++k) d[k] = (sc + k <= qt) ? (gtw[k] | eqw[k]) : 0u; }
    const LAS unsigned* mword = selc + mq * 65 + mhh;
    v4u kreg = *(const GAS v4u*)(ksrc + (size_t)(NT - 1) * 64 * KP), vreg = *(const GAS v4u*)(vsrc + (size_t)(NT - 1) * 64 * KP);
    v4u kreg2 = (v4u){0u, 0u, 0u, 0u}, vreg2 = kreg2;
    if (NT > 1) { kreg2 = *(const GAS v4u*)(ksrc + (size_t)(NT - 2) * 64 * KP); vreg2 = *(const GAS v4u*)(vsrc + (size_t)(NT - 2) * 64 * KP); }
    const float sb = *(const LAS float*)(lds + AT_QKB + 4);
    bf16x8 qr[4];
    { const bf16* Qw = Q + (rowb + q0w + r32) * 512 + w * 64 + hi * 8;
#pragma unroll
      for (int d0 = 0; d0 < 4; ++d0) qr[d0] = *(const bf16x8*)(Qw + d0 * 16); }
    bf16x8 idn[2];
    { const int e = r32 - 4 * hi; const bool val = (e >= 0) && ((e & 4) == 0); const int kss = e >> 4, js = (e & 3) + 4 * ((e >> 3) & 1);
      const unsigned one = val ? (0x3f80u << (16 * (js & 1))) : 0u; const int dw = js >> 1;
#pragma unroll
      for (int ks = 0; ks < 2; ++ks) { v4u f; f.x = (kss == ks && dw == 0) ? one : 0u; f.y = (kss == ks && dw == 1) ? one : 0u; f.z = (kss == ks && dw == 2) ? one : 0u; f.w = (kss == ks && dw == 3) ? one : 0u;
          idn[ks] = __builtin_bit_cast(bf16x8, f); } }
#define DSA_MWRITE(t_, slotoff) do { const unsigned nib_ = (mword[2 * (t_)] >> msh) & 0xfu; v2u mv_; \
        mv_.x = ((nib_ & 1u) ? 0u : 0xf14au) | ((nib_ & 2u) ? 0u : 0xf14a0000u); mv_.y = ((nib_ & 4u) ? 0u : 0xf14au) | ((nib_ & 8u) ? 0u : 0xf14a0000u); \
        *(LAS v2u*)(lds + mdst + (slotoff)) = mv_; } while (0)
    *(LAS v4u*)(lds + kdst) = kreg; *(LAS v4u*)(lds + vdst) = vreg;
    LDS_WAIT(); __syncthreads();
    DSA_MWRITE(NT - 1, 0);
    float mref = SREF ? 0.f : -sb; f32x16 l = f32x16{}; f32x16 o[2]; o[0] = f32x16{}; o[1] = f32x16{};
    f32x16 negm;
#pragma unroll
    for (int r = 0; r < 16; ++r) negm[r] = SREF ? 0.f : sb;
    LDS_WAIT(); __syncthreads();
    asm volatile("" : "+v"(qr[0]), "+v"(qr[1]), "+v"(qr[2]), "+v"(qr[3]));
    auto step = [&](const int it, v4u& kL, v4u& vL, const v4u& kW, const v4u& vW) __attribute__((always_inline)) {
        const int t = NT - 1 - it; const int slot = (it & 1) * 8192, mslot = (it & 1) * 4096;
        if (t > 1) { kL = *(const GAS v4u*)(ksrc + (size_t)(t - 2) * 64 * KP); vL = *(const GAS v4u*)(vsrc + (size_t)(t - 2) * 64 * KP); }
        {
            f32x16 p0, p1;
            const LAS unsigned char* kb = lds + AT_K + (it & 1) * AT_KSLOT + hi * AT_KCH + r32 * 16; const LAS unsigned char* mb = lds + AT_M + mslot + lane * 16;
            bf16x8 kfr[8], mfr[4];
#pragma unroll
            for (int d0 = 0; d0 < 4; ++d0) { kfr[2 * d0] = *(const LAS bf16x8*)(kb + d0 * (2 * AT_KCH)); kfr[2 * d0 + 1] = *(const LAS bf16x8*)(kb + d0 * (2 * AT_KCH) + 512); }
#pragma unroll
            for (int ks = 0; ks < 2; ++ks) { mfr[2 * ks] = *(const LAS bf16x8*)(mb + ks * 1024); mfr[2 * ks + 1] = *(const LAS bf16x8*)(mb + 2048 + ks * 1024); }
            __builtin_amdgcn_sched_barrier(0);
            p0 = MFMA32(kfr[0], qr[0], negm); p1 = MFMA32(kfr[1], qr[0], negm);
#pragma unroll
            for (int d0 = 1; d0 < 4; ++d0) { p0 = MFMA32(kfr[2 * d0], qr[d0], p0); p1 = MFMA32(kfr[2 * d0 + 1], qr[d0], p1); }
#pragma unroll
            for (int ks = 0; ks < 2; ++ks) { p0 = MFMA32(idn[ks], mfr[2 * ks], p0); p1 = MFMA32(idn[ks], mfr[2 * ks + 1], p1); }
            if (64 * t + 63 + 113 > q0w) {
                int rel0 = q0w + r32 - 64 * t - 4 * hi; rel0 = rel0 > 172 ? 172 : rel0;
                const LAS float* lb = lut + rel0;
#pragma unroll
                for (int r = 0; r < 16; ++r) { const int cr = (r & 3) + 8 * (r >> 2); p0[r] += lb[-cr]; p1[r] += lb[-cr - 32]; } }
            const float mold = mref;
            softmax_pv<SREF>(p0, p1, mref, l, o, wsf, lds + AT_V + slot, lane, r32, hi);
            if constexpr (!SREF) { if (mref != mold) {
#pragma unroll
                for (int r = 0; r < 16; ++r) negm[r] = -mref; } }
        }
        if (t > 0) { const int ns = ((it + 1) & 1) * 8192, nk = ((it + 1) & 1) * AT_KSLOT; *(LAS v4u*)(lds + kdst + nk) = kW; *(LAS v4u*)(lds + vdst + ns) = vW; DSA_MWRITE(t - 1, ((it + 1) & 1) * 4096); }
        LDS_WAIT(); __syncthreads();
    };
    for (int it = 0; it < NT; it += 2) {
        step(it, kreg, vreg, kreg2, vreg2);
        if (it + 1 < NT) step(it + 1, kreg2, vreg2, kreg, vreg);
    }
#undef DSA_MWRITE
    attn_store(l, o, wsf, (LAS bf16*)(lds + AT_OST) + w * 2048, O + (rowb + q0w) * 512 + w * 64, lane, r32, hi);
    LDS_WAIT(); __syncthreads();
}

struct Args { const float* in[20]; float* out; unsigned char* ws; int ph_lo, ph_hi, li, pad; };
__global__ void __launch_bounds__(NTHREADS, 2) hyb_fwd(Args args) {
    extern __shared__ __attribute__((aligned(16))) unsigned char lds_raw[];
    LAS unsigned char* lds = (LAS unsigned char*)lds_raw;
    volatile LAS unsigned* MISC = (volatile LAS unsigned*)(lds + MISC_OFF);
    const int wave = __builtin_amdgcn_readfirstlane((int)threadIdx.x >> 6);
#define TID_LANE const int lane = fresh_lane(), tid = wave * 64 + lane; (void)tid; (void)lane
    const int G = gridDim.x; const int bx = blockIdx.x; const int vcu = (G % 8 == 0) ? (bx % 8) * (G / 8) + bx / 8 : bx;
    unsigned char* ws = args.ws;
    gu32* ctl = (gu32*)(ws + WS_CTL);
    const float* x = args.in[0]; const float* n1 = args.in[1]; const float* wg1 = args.in[2]; const float* wu1 = args.in[3]; const float* wd1 = args.in[4];
    const float* nm = args.in[5]; const float* win = args.in[6]; const float* bforget = args.in[7]; const float* gfq = args.in[8]; const float* gfk = args.in[9];
    const float* gdq = args.in[10]; const float* gdk = args.in[11]; const float* relb = args.in[12]; const float* wa = args.in[13]; const float* wb = args.in[14];
    const float* wout = args.in[15]; const float* n2 = args.in[16]; const float* wg2 = args.in[17]; const float* wu2 = args.in[18]; const float* wd2 = args.in[19];
    float* out = args.out;
    bf16* Wgu1 = (bf16*)(ws + WS_WGU1); bf16* Wd1 = (bf16*)(ws + WS_WD1); bf16* Win = (bf16*)(ws + WS_WIN); bf16* Wa = (bf16*)(ws + WS_WA); bf16* Wb = (bf16*)(ws + WS_WB);
    bf16* Wout = (bf16*)(ws + WS_WOUT); bf16* Wgu2 = (bf16*)(ws + WS_WGU2); bf16* Wd2 = (bf16*)(ws + WS_WD2);
    bf16* XB = (bf16*)(ws + WS_XB); float* SS = (float*)(ws + WS_SS); float* LOGF2 = (float*)(ws + WS_LOGF); float* CUM2 = (float*)(ws + WS_CUM); float* IWS = (float*)(ws + WS_IW);
    unsigned* SEL = (unsigned*)(ws + WS_SEL);
    bf16* FQ = (bf16*)(ws + WS_FQ); bf16* DQ = (bf16*)(ws + WS_DQ); bf16* FK = (bf16*)(ws + WS_FK); bf16* FV = (bf16*)(ws + WS_FV); bf16* IQ = (bf16*)(ws + WS_IQ);
    bf16* DK = (bf16*)(ws + WS_DK); bf16* DV = (bf16*)(ws + WS_DV); bf16* IK = (bf16*)(ws + WS_IK); bf16* GA = (bf16*)(ws + WS_GA); bf16* GB = (bf16*)(ws + WS_GB);
    bf16* HB = (bf16*)(ws + WS_H); bf16* MG = (bf16*)(ws + WS_MG);
    const pg8::HMap hmap{(const char*)GA, (const char*)GB, (const char*)MG, (const char*)FQ};

    { TID_LANE; for (int u = tid; u < (LDS_BYTES - LDSCTL_OFF) / 4; u += NTHREADS) ((LAS unsigned*)(lds + LDSCTL_OFF))[u] = 0u; }
    __syncthreads();
    XcdBarrier bar; bar.bar = (unsigned*)(ctl + CW_BAR); bar.x = 0; bar.st = nullptr;
    if (N_LAUNCHES == 1) bar = xcd_barrier_post((unsigned*)(ctl + CW_BAR), MISC + 8, wave == 0 && fresh_lane() == 0);
    const int lo = args.ph_lo, hi = args.ph_hi;
#ifndef PROBE_DUP
#define PROBE_DUP 0
#endif
#define REP(k) for (int rep_ = 0; rep_ < (((PROBE_DUP >> (k)) & 1) ? 2 : 1); ++rep_)
#define IN(k) (lo <= (k) && (k) < hi)
#define SEAM(k) do { if (IN(k) && IN((k) + 1)) xcd_barrier(bar, wave == 0 && fresh_lane() == 0); } while (0)
#define SEAML(k) do { if (IN(k) && IN((k) + 1)) { if (uni) xcd_local_barrier(bar, wave == 0 && fresh_lane() == 0); else xcd_barrier(bar, wave == 0 && fresh_lane() == 0); } } while (0)

    const P0Args p0a{x, n1, wg1, wu1, wd1, nm, win, wa, wb, wout, n2, wg2, wu2, wd2, Wgu1, Wd1, Win, Wa, Wb, Wout, Wgu2, Wd2, XB, SS};
    if (IN(0)) { TID_LANE;
        REP(0) p0_prologue(p0a, lds, vcu, G, wave, lane);
        SEAM(0);
    }
    const bool uni = (N_LAUNCHES == 1) && (MISC[8 + 6] != 0u);
    const int vb = uni ? (int)(MISC[8 + 4] * 8u + MISC[8 + 5]) : bx;
    const int vcu2 = (G % 8 == 0) ? (vb % 8) * (G / 8) + vb / 8 : vb;
    if (IN(1)) { TID_LANE;
        pg8::Gemm g{XB, Wgu1, TOK, NGU, DM, XB, Wgu1}; pg8::StaticOrder S; S.init(TOK, NGU, G, vb);
        pg8::EpiGateUp<true> E{hmap, SS, lds};
        REP(1) pg8::gemm_phase<pg8::EpiGateUp<true>, pg8::StaticOrder, true, true>(lds, g, S, E, wave, lane);
        SEAML(1);
    }
    if (IN(2)) { TID_LANE;
        pg8::Gemm g{HB, Wd1, TOK, DM, DFF, HB, Wd1, hmap}; pg8::StaticOrder S; S.init(TOK, DM, G, vb);
        pg8::EpiRes<false, true, false, 1> E{x, nullptr, XB, SS + (size_t)TOK * 16};
        pg8::gemm_phase<pg8::EpiRes<false, true, false, 1>, pg8::StaticOrder, true, true>(lds, g, S, E, wave, lane);
        SEAML(2);
    }
    if (IN(3)) { TID_LANE;
        pg8::Gemm g{XB, Win, TOK, NIN, DM, XB, Win}; pg8::StaticOrder S; S.init(TOK, NIN, G, vb);
        if (tid < 256) { const float* gsrc = (tid < 64) ? gfq : (tid < 128) ? gfk : (tid < 192) ? gdq : gdk; *(LAS float*)(lds + pg8::GAIN_LDS + 4 * tid) = gsrc[tid & 63]; }
        if (tid < 8) *(LAS float*)(lds + pg8::BF_LDS + 4 * tid) = bforget[tid];
        pg8::EpiWin E{SS + (size_t)TOK * 16, FQ, FK, FV, DQ, DK, DV, IQ, IK, GA, GB, LOGF2, IWS, bforget, lds};
        REP(3) pg8::gemm_phase<pg8::EpiWin, pg8::StaticOrder, true, true>(lds, g, S, E, wave, lane);
        SEAML(3);
    }
    if (IN(4)) { TID_LANE;
        { LAS float* lut = (LAS float*)(lds + AT_LUT);
          for (int i = tid; i < 8 * LUTW; i += NTHREADS) { const int hh = i / LUTW; int rel = i - hh * LUTW - 64; rel = rel < 0 ? 0 : (rel > 127 ? 127 : rel); lut[i] = (relb[t5_bucket(rel) * 8 + hh] - relb[31 * 8 + hh]) * LOG2E; }
          if (wave == 0) { float mq = __builtin_fabsf(gfq[lane]), mk = __builtin_fabsf(gfk[lane]), dq = __builtin_fabsf(gdq[lane]), dk = __builtin_fabsf(gdk[lane]);
              float mb = 0.f;
#pragma unroll
              for (int i = 0; i < 4; ++i) { const int idx = lane + 64 * i; mb = __builtin_fmaxf(mb, __builtin_fabsf(relb[idx] - relb[31 * 8 + (idx & 7)])); }
#pragma unroll
              for (int o = 1; o < 64; o <<= 1) { mq = __builtin_fmaxf(mq, __shfl_xor(mq, o)); mk = __builtin_fmaxf(mk, __shfl_xor(mk, o)); dq = __builtin_fmaxf(dq, __shfl_xor(dq, o)); dk = __builtin_fmaxf(dk, __shfl_xor(dk, o)); mb = __builtin_fmaxf(mb, __shfl_xor(mb, o)); }
              if (lane == 0) { *(LAS float*)(lds + AT_QKB) = 64.0f * C2 * mq * mk * 1.02f;
                               *(LAS float*)(lds + AT_QKB + 4) = 64.0f * C2 * dq * dk * 1.02f + mb * LOG2E; } }
          LDS_WAIT(); __syncthreads(); }
        const bool sref = (2.0f * *(const LAS float*)(lds + AT_QKB) < 96.0f) && (2.0f * *(const LAS float*)(lds + AT_QKB + 4) < 96.0f);
        for (int it = vcu2; it < 256; it += G) {
            { const int pr = it >> 1, b = pr >> 3, h = pr & 7, odd = it & 1;
              cumsum_unit(lds, LOGF2 + (size_t)pr * SEQ, (LAS float*)(lds + AT_CUM), tid, wave, lane);
#pragma unroll 1
              for (int i = 0; i < 4; ++i) { const int qb = odd ? ((i == 0) ? 1 : (i == 1) ? 6 : (i == 2) ? 3 : 4) : ((i == 0) ? 0 : (i == 1) ? 7 : (i == 2) ? 2 : 5);
                  if (sref) fox_unit<true>(lds, b, h, qb, FQ, FK, FV, FQ, CUM2, tid, wave, lane); else fox_unit<false>(lds, b, h, qb, FQ, FK, FV, FQ, CUM2, tid, wave, lane); } }
            { const int b = it >> 4, s = it & 15;
              constexpr unsigned QT4[16] = {0x002a1d3cu, 0x071e213fu, 0x021c2c39u, 0x031b2d3au, 0x011a2e3bu, 0x05182f38u, 0x061f243du, 0x0419283eu,
                                            0x0e162036u, 0x09172637u, 0x0a142734u, 0x08152932u, 0x0c122235u, 0x0d132333u, 0x0b102b30u, 0x0f112531u};
              unsigned qts = 0u;
#pragma unroll
              for (int k = 0; k < 16; ++k) qts = (s == k) ? QT4[k] : qts;
#pragma unroll 1
              for (int i = 0; i < 4; ++i) { const int qt = (int)((qts >> (24 - 8 * i)) & 0xffu);
                  idx_unit(lds, b, qt, IQ, IK, IWS, SEL, tid, wave, lane);
                  if (sref) dsa_unit<true>(lds, b, qt, DQ, DK, DV, DQ, SEL, tid, wave, lane); else dsa_unit<false>(lds, b, qt, DQ, DK, DV, DQ, SEL, tid, wave, lane); } }
        }
        SEAML(4);
    }
    if (IN(6)) { TID_LANE;
        pg8::Gemm g{FQ, Wa, TOK, DM, HW, DQ, Wb}; pg8::PairOrder S; S.so.init(TOK, DM, G, vb);
        pg8::EpiBranch E{GA, GB, MG};
        REP(6) pg8::gemm_phase<pg8::EpiBranch, pg8::PairOrder, true, true>(lds, g, S, E, wave, lane);
        SEAML(6);
    }
    if (IN(7)) { TID_LANE;
        pg8::Gemm g{MG, Wout, TOK, DM, DM, MG, Wout}; pg8::StaticOrder S; S.init(TOK, DM, G, vb);
        pg8::EpiRes<true, true, false, 2> E{nullptr, nullptr, XB, SS + (size_t)2 * TOK * 16};
        pg8::gemm_phase<pg8::EpiRes<true, true, false, 2>, pg8::StaticOrder, true, true>(lds, g, S, E, wave, lane);
        SEAML(7);
    }
    if (IN(8)) { TID_LANE;
        pg8::Gemm g{XB, Wgu2, TOK, NGU, DM, XB, Wgu2}; pg8::StaticOrder S; S.init(TOK, NGU, G, vb);
        pg8::EpiGateUp<false> E{hmap, SS + (size_t)2 * TOK * 16, lds};
        REP(8) pg8::gemm_phase<pg8::EpiGateUp<false>, pg8::StaticOrder, true, true>(lds, g, S, E, wave, lane);
        SEAML(8);
    }
    if (IN(9)) { TID_LANE;
        pg8::Gemm g{HB, Wd2, TOK, DM, DFF, HB, Wd2, hmap}; pg8::StaticOrder S; S.init(TOK, DM, G, vb);
        pg8::EpiRes<true, false, true, 1> E{nullptr, out, XB, nullptr};
        pg8::gemm_phase<pg8::EpiRes<true, false, true, 1>, pg8::StaticOrder, true, true>(lds, g, S, E, wave, lane);
    }
#undef IN
#undef REP
#undef SEAM
}

extern "C" void kernel_launch(void* const* d_in, const int* in_sizes, int n_in, void* d_out, int out_size, void* d_ws, size_t ws_size, hipStream_t stream) {
    static int grid = 0;
    if (grid == 0) {
        if (n_in != 20 || in_sizes[0] != TOK * DM || out_size != TOK * DM || ws_size < WS_END) { fprintf(stderr, "kernel_launch: unexpected shapes (n_in %d, in0 %d, out %d, ws %zu); nothing launched\n", n_in, n_in > 0 ? in_sizes[0] : -1, out_size, ws_size); grid = -1; return; }
        int dev = 0, cus = 0, per_cu = 0;
        if (hipGetDevice(&dev) != hipSuccess || hipDeviceGetAttribute(&cus, hipDeviceAttributeMultiprocessorCount, dev) != hipSuccess) { grid = -1; return; }
        if (hipFuncSetAttribute((const void*)hyb_fwd, hipFuncAttributeMaxDynamicSharedMemorySize, LDS_BYTES) != hipSuccess) { fprintf(stderr, "kernel_launch: hipFuncSetAttribute failed\n"); grid = -1; return; }
        if (hipOccupancyMaxActiveBlocksPerMultiprocessor(&per_cu, (const void*)hyb_fwd, NTHREADS, LDS_BYTES) != hipSuccess || per_cu < 1) { fprintf(stderr, "kernel_launch: occupancy query says %d blocks per CU\n", per_cu); per_cu = 1; }
        (void)hipGetLastError();
        grid = cus;
    }
    if (grid < 0) return;
    if (hipMemsetAsync((char*)d_ws + WS_CTL, 0, CTL_ZERO_BYTES, stream) != hipSuccess) return;
    Args a{};
    for (int i = 0; i < 20; ++i) a.in[i] = (const float*)d_in[i];
    a.out = (float*)d_out; a.ws = (unsigned char*)d_ws;
    if (N_LAUNCHES == 1) {
        a.ph_lo = 0; a.ph_hi = NPHASE; a.li = 0;
        hipLaunchKernelGGL(hyb_fwd, dim3(grid), dim3(NTHREADS), LDS_BYTES, stream, a);
    } else {
        for (int li = 0; li < NPHASE; ++li) { a.ph_lo = li; a.ph_hi = li + 1; a.li = li; hipLaunchKernelGGL(hyb_fwd, dim3(grid), dim3(NTHREADS), LDS_BYTES, stream, a); }
    }
    const hipError_t le = hipPeekAtLastError();
    if (le != hipSuccess) fprintf(stderr, "kernel_launch: launch failed: %s\n", hipGetErrorName(le));
}
```
